# Optimizing an MI355X kernel written in HIP

```python
import jax, jax.numpy as jnp
from jax import lax
import numpy as np

D_MODEL = 1024
BATCH = 4
SEQ = 4096
DEPTH = 1
DEC_BATCH = 128
DEC_SEQ = 4
PAST_LEN = 2048
PAGE_SIZE = 128

A_HEADS = 8
A_HEAD_DIM = 64
A_WIDTH = A_HEADS * A_HEAD_DIM
Q_BLOCK = 128
B_HEADS = 4
B_HEAD_DIM = 128
B_WIDTH = B_HEADS * B_HEAD_DIM
CONV_W = 4
MLSTM_CHUNK = 64
D_FF = 4 * D_MODEL
N_MOD = 6
RMS_EPS = 1e-6
NEG_INF = -1e30

kernel_name = 'fox_mlstm_hybrid_step'


def _split_points():
    sizes = (A_WIDTH, A_WIDTH, A_WIDTH, A_HEADS, B_WIDTH, B_WIDTH, B_WIDTH, B_HEADS, B_HEADS, B_WIDTH, D_MODEL, D_MODEL)
    return [int(s) for s in np.cumsum(sizes)[:-1]]


def _n_in():
    return 3 * A_WIDTH + A_HEADS + 4 * B_WIDTH + 2 * B_HEADS + 2 * D_MODEL


def rmsnorm(x, g):
    xf = x.astype(jnp.float32)
    r = lax.rsqrt(jnp.mean(xf * xf, axis=-1, keepdims=True) + RMS_EPS)
    return (xf * r).astype(x.dtype) * g


def fox_attention(q, fq, qpos, k, v, fk, kpos):
    b, l, h, d = q.shape
    qb = min(Q_BLOCK, l)
    nb = l // qb
    scale = d ** -0.5
    fk_t = jnp.transpose(fk, (0, 2, 1))

    def block(args):
        qi, fqi, pi = args
        s = jnp.einsum('bqhd,bkhd->bhqk', qi, k).astype(jnp.float32) * scale
        s = s + jnp.transpose(fqi, (0, 2, 1))[..., None] - fk_t[:, :, None, :]
        s = jnp.where(kpos[None, None, None, :] <= pi[None, None, :, None], s, NEG_INF)
        p = jax.nn.softmax(s, axis=-1).astype(v.dtype)
        return jnp.einsum('bhqk,bkhd->bqhd', p, v)

    qs = jnp.moveaxis(q.reshape(b, nb, qb, h, d), 1, 0)
    fs = jnp.moveaxis(fq.reshape(b, nb, qb, h), 1, 0)
    ps = qpos.reshape(nb, qb)
    out = lax.map(block, (qs, fs, ps))
    return jnp.moveaxis(out, 0, 1).reshape(b, l, h, d)


def mlstm_chunkwise(q, k, v, i_pre, logf, c0, n0, m0):
    f32 = jnp.float32
    b, l, h, dk = q.shape
    dv = v.shape[-1]
    ch = min(MLSTM_CHUNK, l)
    nc = l // ch

    def to_chunks(a):
        return jnp.moveaxis(a.astype(f32).reshape((b, nc, ch) + a.shape[2:]), 1, 0)

    causal = jnp.tril(jnp.ones((ch, ch), dtype=bool))

    def step(carry, xs):
        c, n, m = carry
        qc, kc, vc, ic, fc = xs
        bcum = jnp.cumsum(fc, axis=1)
        dlog = bcum[:, :, None, :] - bcum[:, None, :, :] + ic[:, None, :, :]
        dlog = jnp.where(causal[None, :, :, None], dlog, NEG_INF)
        inter = bcum + m[:, None, :]
        mt = jnp.maximum(inter, jnp.max(dlog, axis=2))
        a = jnp.exp(dlog - mt[:, :, None, :]) * jnp.einsum('bthd,bshd->btsh', qc, kc)
        si = jnp.exp(inter - mt)
        num = jnp.einsum('btsh,bshe->bthe', a, vc) + si[..., None] * jnp.einsum('bthd,bhde->bthe', qc, c)
        den = jnp.sum(a, axis=2) + si * jnp.einsum('bthd,bhd->bth', qc, n)
        hc = num / jnp.maximum(jnp.abs(den), jnp.exp(-mt))[..., None]
        bl = bcum[:, -1, :]
        wlog = bl[:, None, :] - bcum + ic
        m_new = jnp.maximum(bl + m, jnp.max(wlog, axis=1))
        ws = jnp.exp(wlog - m_new[:, None, :])
        decay = jnp.exp(bl + m - m_new)
        c_new = decay[..., None, None] * c + jnp.einsum('bsh,bshd,bshe->bhde', ws, kc, vc)
        n_new = decay[..., None] * n + jnp.einsum('bsh,bshd->bhd', ws, kc)
        return (c_new, n_new, m_new), hc

    xs = (to_chunks(q), to_chunks(k), to_chunks(v), to_chunks(i_pre), to_chunks(logf))
    (c_f, n_f, m_f), hs = lax.scan(step, (c0.astype(f32), n0.astype(f32), m0.astype(f32)), xs)
    return jnp.moveaxis(hs, 0, 1).reshape(b, l, h, dv), c_f, n_f, m_f


def causal_conv(x, prev, w, bias):
    l = x.shape[1]
    xp = jnp.concatenate([prev.astype(x.dtype), x], axis=1)
    y = bias + w[0] * xp[:, 0:l]
    for j in range(1, CONV_W):
        y = y + w[j] * xp[:, j:j + l]
    return jax.nn.silu(y), xp[:, l:]


def hybrid_layer(x, c, k_past, v_past, logf_past, c_state, n_state, m_state, conv_prev, lw):
    (w_ada, b_ada, g_pre_mix, g_post_mix, g_pre_mlp, g_post_mlp, w_in, b_fox_f, b_ml_i, b_ml_f,
     conv_w, conv_b, w_proj_a, w_proj_b, w_out, w_up, w_down) = lw
    f32 = jnp.float32
    bsz, l = x.shape[:2]
    mod = jax.nn.silu(c) @ w_ada + b_ada
    sh_m, sc_m, gt_m, sh_f, sc_f, gt_f = [t[:, None, :] for t in jnp.split(mod, N_MOD, axis=-1)]

    h = rmsnorm(x, g_pre_mix) * (1 + sc_m) + sh_m
    z = h @ w_in
    aq, ak, av, af, bq, bk, bv, bi, bf, bo, ga, gb = jnp.split(z, _split_points(), axis=-1)

    aq = aq.reshape(bsz, l, A_HEADS, A_HEAD_DIM)
    ak = ak.reshape(bsz, l, A_HEADS, A_HEAD_DIM)
    av = av.reshape(bsz, l, A_HEADS, A_HEAD_DIM)
    a_logf = jax.nn.log_sigmoid(af.astype(f32) + b_fox_f)
    if k_past is None:
        p = 0
        keys, vals, lf_all = ak, av, a_logf
    else:
        p = k_past.shape[1]
        keys = jnp.concatenate([k_past.astype(ak.dtype), ak], axis=1)
        vals = jnp.concatenate([v_past.astype(av.dtype), av], axis=1)
        lf_all = jnp.concatenate([logf_past.astype(f32), a_logf], axis=1)
    fk = jnp.cumsum(lf_all, axis=1)
    kpos = jnp.arange(p + l, dtype=jnp.int32)
    ya = fox_attention(aq, fk[:, p:], kpos[p:], keys, vals, fk, kpos)
    ya = ya.reshape(bsz, l, A_WIDTH) @ w_proj_a

    qk_c, conv_new = causal_conv(jnp.concatenate([bq, bk], axis=-1), conv_prev, conv_w, conv_b)
    mq, mk = jnp.split(qk_c, 2, axis=-1)
    mq = mq.reshape(bsz, l, B_HEADS, B_HEAD_DIM)
    mk = mk.reshape(bsz, l, B_HEADS, B_HEAD_DIM) * (B_HEAD_DIM ** -0.5)
    mv = bv.reshape(bsz, l, B_HEADS, B_HEAD_DIM)
    i_pre = bi.astype(f32) + b_ml_i
    b_logf = jax.nn.log_sigmoid(bf.astype(f32) + b_ml_f)
    hb, c_new, n_new, m_new = mlstm_chunkwise(mq, mk, mv, i_pre, b_logf, c_state, n_state, m_state)
    yb = (jax.nn.sigmoid(bo) * hb.reshape(bsz, l, B_WIDTH).astype(x.dtype)) @ w_proj_b

    y = (jax.nn.sigmoid(ga) * ya + jax.nn.sigmoid(gb) * yb) @ w_out
    x = x + gt_m * rmsnorm(y, g_post_mix)

    h2 = rmsnorm(x, g_pre_mlp) * (1 + sc_f) + sh_f
    u = jnp.square(jax.nn.relu(h2 @ w_up))
    x = x + gt_f * rmsnorm(u @ w_down, g_post_mlp)
    return x, ak, av, a_logf, c_new, n_new, m_new, conv_new


def setup_inputs(seed: int = 0) -> dict:
    key = jax.random.key(seed)
    ks = jax.random.split(key, 32)
    f32 = jnp.float32
    n_pages = PAST_LEN // PAGE_SIZE
    n_used = DEC_BATCH * n_pages
    n_phys = n_used + n_used // 4
    n_in = _n_in()

    def nrm(k, shape, s):
        return jax.random.normal(k, shape, f32) * s

    page_table = jax.random.permutation(ks[0], n_phys)[:n_used].reshape(DEC_BATCH, n_pages).astype(jnp.int32)
    return {
        'x_prompt': nrm(ks[1], (BATCH, SEQ, D_MODEL), 1.0),
        'x_sample': nrm(ks[2], (DEC_BATCH, DEC_SEQ, D_MODEL), 1.0),
        'cache_k': nrm(ks[3], (DEPTH, n_phys, PAGE_SIZE, A_HEADS, A_HEAD_DIM), 1.0),
        'cache_v': nrm(ks[4], (DEPTH, n_phys, PAGE_SIZE, A_HEADS, A_HEAD_DIM), 1.0),
        'cache_logf': jax.nn.log_sigmoid(2.0 + nrm(ks[5], (DEPTH, n_phys, PAGE_SIZE, A_HEADS), 1.0)),
        'page_table': page_table,
        'state_C': nrm(ks[6], (DEPTH, DEC_BATCH, B_HEADS, B_HEAD_DIM, B_HEAD_DIM), 0.3),
        'state_n': nrm(ks[7], (DEPTH, DEC_BATCH, B_HEADS, B_HEAD_DIM), 0.3),
        'state_m': nrm(ks[8], (DEPTH, DEC_BATCH, B_HEADS), 1.0),
        'state_conv': nrm(ks[9], (DEPTH, DEC_BATCH, CONV_W - 1, 2 * B_WIDTH), 1.0),
        'c_prompt': nrm(ks[10], (BATCH, D_MODEL), 1.0),
        'c_sample': nrm(ks[11], (DEC_BATCH, D_MODEL), 1.0),
        'w_ada': nrm(ks[12], (DEPTH, D_MODEL, N_MOD * D_MODEL), 0.5 * D_MODEL ** -0.5),
        'b_ada': nrm(ks[13], (DEPTH, N_MOD * D_MODEL), 0.02),
        'g_pre_mix': 1.0 + nrm(ks[14], (DEPTH, D_MODEL), 0.02),
        'g_post_mix': 1.0 + nrm(ks[15], (DEPTH, D_MODEL), 0.02),
        'g_pre_mlp': 1.0 + nrm(ks[16], (DEPTH, D_MODEL), 0.02),
        'g_post_mlp': 1.0 + nrm(ks[17], (DEPTH, D_MODEL), 0.02),
        'w_in': nrm(ks[18], (DEPTH, D_MODEL, n_in), D_MODEL ** -0.5),
        'b_fox_f': 2.0 + nrm(ks[19], (DEPTH, A_HEADS), 0.5),
        'b_ml_i': nrm(ks[20], (DEPTH, B_HEADS), 0.1),
        'b_ml_f': jnp.linspace(3.0, 6.0, B_HEADS, dtype=f32)[None, :] + nrm(ks[21], (DEPTH, B_HEADS), 0.1),
        'conv_w': nrm(ks[22], (DEPTH, CONV_W, 2 * B_WIDTH), CONV_W ** -0.5),
        'conv_b': nrm(ks[23], (DEPTH, 2 * B_WIDTH), 0.02),
        'w_proj_a': nrm(ks[24], (DEPTH, A_WIDTH, D_MODEL), A_WIDTH ** -0.5),
        'w_proj_b': nrm(ks[25], (DEPTH, B_WIDTH, D_MODEL), B_WIDTH ** -0.5),
        'w_out': nrm(ks[26], (DEPTH, D_MODEL, D_MODEL), D_MODEL ** -0.5),
        'w_up': nrm(ks[27], (DEPTH, D_MODEL, D_FF), D_MODEL ** -0.5),
        'w_down': nrm(ks[28], (DEPTH, D_FF, D_MODEL), D_FF ** -0.5),
    }


def reference(x_prompt, x_sample, cache_k, cache_v, cache_logf, page_table, state_C, state_n, state_m, state_conv,
              c_prompt, c_sample, w_ada, b_ada, g_pre_mix, g_post_mix, g_pre_mlp, g_post_mlp, w_in, b_fox_f,
              b_ml_i, b_ml_f, conv_w, conv_b, w_proj_a, w_proj_b, w_out, w_up, w_down):
    f32 = jnp.float32
    bsz = x_prompt.shape[0]
    dbsz = x_sample.shape[0]
    n_pages = page_table.shape[1]
    past = n_pages * PAGE_SIZE
    y_prompt, y_sample = x_prompt, x_sample
    kp, vp, lfp, cp, nps, mp, cvp = [], [], [], [], [], [], []
    ksm, vsm, lfs, cs, nss, ms, cvs = [], [], [], [], [], [], []
    for layer in range(DEPTH):
        lw = (w_ada[layer], b_ada[layer], g_pre_mix[layer], g_post_mix[layer], g_pre_mlp[layer], g_post_mlp[layer],
              w_in[layer], b_fox_f[layer], b_ml_i[layer], b_ml_f[layer], conv_w[layer], conv_b[layer],
              w_proj_a[layer], w_proj_b[layer], w_out[layer], w_up[layer], w_down[layer])
        c0 = jnp.zeros((bsz, B_HEADS, B_HEAD_DIM, B_HEAD_DIM), f32)
        n0 = jnp.zeros((bsz, B_HEADS, B_HEAD_DIM), f32)
        m0 = jnp.zeros((bsz, B_HEADS), f32)
        cv0 = jnp.zeros((bsz, CONV_W - 1, 2 * B_WIDTH), x_prompt.dtype)
        y_prompt, k1, v1, lf1, c1, n1, m1, cv1 = hybrid_layer(y_prompt, c_prompt, None, None, None, c0, n0, m0, cv0, lw)
        k_past = cache_k[layer][page_table].reshape(dbsz, past, A_HEADS, A_HEAD_DIM)
        v_past = cache_v[layer][page_table].reshape(dbsz, past, A_HEADS, A_HEAD_DIM)
        lf_past = cache_logf[layer][page_table].reshape(dbsz, past, A_HEADS)
        y_sample, k2, v2, lf2, c2, n2, m2, cv2 = hybrid_layer(
            y_sample, c_sample, k_past, v_past, lf_past, state_C[layer], state_n[layer], state_m[layer],
            state_conv[layer], lw)
        kp.append(k1); vp.append(v1); lfp.append(lf1); cp.append(c1); nps.append(n1); mp.append(m1); cvp.append(cv1)
        ksm.append(k2); vsm.append(v2); lfs.append(lf2); cs.append(c2); nss.append(n2); ms.append(m2); cvs.append(cv2)
    new_k_prompt = jnp.stack(kp)
    new_v_prompt = jnp.stack(vp)
    new_logf_prompt = jnp.stack(lfp)
    new_C_prompt = jnp.stack(cp)
    new_n_prompt = jnp.stack(nps)
    new_m_prompt = jnp.stack(mp)
    new_conv_prompt = jnp.stack(cvp)
    new_k_sample = jnp.stack(ksm)
    new_v_sample = jnp.stack(vsm)
    new_logf_sample = jnp.stack(lfs)
    new_C_sample = jnp.stack(cs)
    new_n_sample = jnp.stack(nss)
    new_m_sample = jnp.stack(ms)
    new_conv_sample = jnp.stack(cvs)
    return (y_prompt, y_sample, new_k_prompt, new_v_prompt, new_logf_prompt, new_C_prompt, new_n_prompt,
            new_m_prompt, new_conv_prompt, new_k_sample, new_v_sample, new_logf_sample, new_C_sample,
            new_n_sample, new_m_sample, new_conv_sample)
```

```cpp
#define MK_N_LAUNCHES 1
#include <hip/hip_runtime.h>
#include <cstdio>
#include <cstdint>
namespace pg8 {
#define PG8_LAS __attribute__((address_space(3)))
typedef unsigned short bf16_t;
typedef short bf16x8 __attribute__((ext_vector_type(8)));
typedef float f32x4 __attribute__((ext_vector_type(4)));
typedef unsigned u32x4 __attribute__((ext_vector_type(4)));
constexpr int BM = 256, BK = 64, HALF = 128, HTB = HALF * BK * 2  , STAGE_BYTES = 8 * HTB, NXCD = 8, WGM = 8;

__host__ __device__ __forceinline__ int lds_byte(int r, int c) { const int st = (r >> 4) * 2 + (c >> 5), rr = r & 15, cc = c & 31, ob = rr * 64 + cc * 2; return st * 1024 + (ob ^ (((ob >> 9) & 1) << 5)); }
__host__ __device__ __forceinline__ void stage_rc(int b, int& R, int& C) { const int st = b / 1024, sb = b % 1024, swz = sb ^ (((sb >> 9) & 1) << 5); R = (st >> 1) * 16 + swz / 64; C = (st & 1) * 32 + (swz % 64) / 2; }
__host__ __device__ __forceinline__ int perm32(int rho) { const int n = rho >> 4, i = rho & 15; return 8 * (i >> 2) + 4 * n + (i & 3); }

struct Unit { int pm, pn; };
struct Gemm { const bf16_t* A; const bf16_t* Bt; int M, N, K; };

struct StaticOrder {
    int nM, nN, nwg, G, c;
    __host__ __device__ void init(int M, int N, int G_, int c_) { nM = M / BM; nN = N / BM; nwg = nM * nN; G = G_; c = c_; }
    __host__ __device__ bool next(int i, Unit& u) const {
        const long L = (long)i * G + c; if (L >= nwg) return false;
        int wgid = (int)L; { const int q = nwg / NXCD, r = nwg % NXCD, xcd = wgid % NXCD, off = wgid / NXCD; wgid = (xcd < r ? xcd * (q + 1) : r * (q + 1) + (xcd - r) * q) + off; }
        const int nig = WGM * nN, gid = wgid / nig, fm = gid * WGM, gsz = (nM - fm) < WGM ? (nM - fm) : WGM;
        u.pm = fm + ((wgid % nig) % gsz); u.pn = (wgid % nig) / gsz; return true;
    }
    __device__ __forceinline__ void a_ready(const Unit&) const {}
    __device__ __forceinline__ void done(const Unit&) const {}
};

__device__ __forceinline__ unsigned cvt_pk_bf16(float lo, float hi) { unsigned r; asm volatile("v_cvt_pk_bf16_f32 %0, %1, %2" : "=v"(r) : "v"(lo), "v"(hi)); return r; }
typedef float f32x2 __attribute__((ext_vector_type(2)));
typedef unsigned short u16x8v __attribute__((ext_vector_type(8)));
__device__ __forceinline__ float bf2f(unsigned short b) { return __uint_as_float(((unsigned)b) << 16); }
__device__ __forceinline__ float sigm(float x) { return 1.0f / (1.0f + __expf(-x)); }
__device__ __forceinline__ float logsig(float x) { return fminf(x, 0.f) - log1pf(__expf(-fabsf(x))); }
__device__ __forceinline__ u32x4 pack8(const f32x4 v0, const f32x4 v1) { u32x4 w; w.x = cvt_pk_bf16(v0[0], v0[1]); w.y = cvt_pk_bf16(v0[2], v0[3]); w.z = cvt_pk_bf16(v1[0], v1[1]); w.w = cvt_pk_bf16(v1[2], v1[3]); return w; }

#define PG8_EPI_WALK(...) \
    _Pragma("unroll") for (int ai = 0; ai < 2; ++ai) _Pragma("unroll") for (int m = 0; m < 4; ++m) { const int row = u.pm * BM + ai * HALF + wr * 64 + m * 16 + fr; \
        _Pragma("unroll") for (int bj = 0; bj < 2; ++bj) { const int cl = bj * HALF + wc * 32 + 8 * fq; f32x4 v0 = acc[ai][bj][m][0], v1 = acc[ai][bj][m][1]; __VA_ARGS__ } }

struct EpiF32 {
    static constexpr bool PERM = true, AFTER_DRAIN = false;
    float* O; int ldc; const float* bias;
    __device__ __forceinline__ void operator()(const f32x4 (&acc)[2][2][4][2], const Unit& u, int wr, int wc, int fr, int fq) const {
        PG8_EPI_WALK({ const int col = u.pn * BM + cl; if (bias) { v0 += *(const f32x4*)(bias + col); v1 += *(const f32x4*)(bias + col + 4); }
            float* p = O + (size_t)row * ldc + col; *(f32x4*)p = v0; *(f32x4*)(p + 4) = v1; })
    }
};
struct EpiRelu2 {
    static constexpr bool PERM = true, AFTER_DRAIN = false;
    bf16_t* O; int ldc;
    __device__ __forceinline__ void operator()(const f32x4 (&acc)[2][2][4][2], const Unit& u, int wr, int wc, int fr, int fq) const {
        PG8_EPI_WALK({ const int col = u.pn * BM + cl;
            _Pragma("unroll") for (int e = 0; e < 4; ++e) { const float a = fmaxf(v0[e], 0.f), b = fmaxf(v1[e], 0.f); v0[e] = a * a; v1[e] = b * b; }
            *(u32x4*)(O + (size_t)row * ldc + col) = pack8(v0, v1); })
    }
};
struct EpiGateA {
    static constexpr bool PERM = true, AFTER_DRAIN = false;
    float* T1; const bf16_t* SG; int ldc;
    __device__ __forceinline__ void operator()(const f32x4 (&acc)[2][2][4][2], const Unit& u, int wr, int wc, int fr, int fq) const {
        PG8_EPI_WALK({ const int col = u.pn * BM + cl; const size_t off = (size_t)row * ldc + col;
            const u16x8v g = *(const u16x8v*)(SG + off);
            _Pragma("unroll") for (int e = 0; e < 4; ++e) { v0[e] *= bf2f(g[e]); v1[e] *= bf2f(g[4 + e]); }
            *(f32x4*)(T1 + off) = v0; *(f32x4*)(T1 + off + 4) = v1; })
    }
};
struct EpiGateB {
    static constexpr bool PERM = true, AFTER_DRAIN = false;
    const float* T1; const bf16_t* SG; bf16_t* T; int ldc;
    __device__ __forceinline__ void operator()(const f32x4 (&acc)[2][2][4][2], const Unit& u, int wr, int wc, int fr, int fq) const {
        PG8_EPI_WALK({ const int col = u.pn * BM + cl; const size_t off = (size_t)row * ldc + col;
            const u16x8v g = *(const u16x8v*)(SG + off); const f32x4 t0 = *(const f32x4*)(T1 + off), t1 = *(const f32x4*)(T1 + off + 4);
            _Pragma("unroll") for (int e = 0; e < 4; ++e) { v0[e] = t0[e] + v0[e] * bf2f(g[e]); v1[e] = t1[e] + v1[e] * bf2f(g[4 + e]); }
            *(u32x4*)(T + off) = pack8(v0, v1); })
    }
};
struct EpiIn {
    static constexpr bool PERM = true, AFTER_DRAIN = false;
    bf16_t *QA, *KA, *VA, *QKB, *VB, *SBO, *SGA, *SGB; float *LFA, *IPRE, *LFB; float* out; const float *b_fox, *b_mli, *b_mlf;
    int MPr, o_kp, o_vp, o_lfp, o_cvp, o_ks, o_vs, o_lfs, o_cvs; float qscale;
    __device__ __forceinline__ void operator()(const f32x4 (&acc)[2][2][4][2], const Unit& u, int wr, int wc, int fr, int fq) const {
        const int pn = u.pn;
        if (pn == 22) {
            if (wc != 0 || fq > 1) return;
#pragma unroll
            for (int ai = 0; ai < 2; ++ai)
#pragma unroll
                for (int m = 0; m < 4; ++m) { const int row = u.pm * BM + ai * HALF + wr * 64 + m * 16 + fr; f32x4 v0 = acc[ai][0][m][0], v1 = acc[ai][0][m][1];
                    if (fq == 0) {
#pragma unroll
                        for (int e = 0; e < 4; ++e) { v0[e] = logsig(v0[e] + b_fox[e]); v1[e] = logsig(v1[e] + b_fox[4 + e]); }
                        *(f32x4*)(LFA + (size_t)row * 8) = v0; *(f32x4*)(LFA + (size_t)row * 8 + 4) = v1;
                        float* o = out + (row < MPr ? (size_t)o_lfp + (size_t)row * 8 : (size_t)o_lfs + (size_t)(row - MPr) * 8); *(f32x4*)o = v0; *(f32x4*)(o + 4) = v1;
                    } else {
#pragma unroll
                        for (int e = 0; e < 4; ++e) { v0[e] = v0[e] + b_mli[e]; v1[e] = logsig(v1[e] + b_mlf[e]); }
                        *(f32x4*)(IPRE + (size_t)row * 4) = v0; *(f32x4*)(LFB + (size_t)row * 4) = v1;
                    } }
            return;
        }
        bf16_t* dst; int ld, cb, mode;
        if (pn < 2) { dst = QA; ld = 512; cb = pn * BM; mode = 0; }
        else if (pn < 4) { dst = KA; ld = 512; cb = (pn - 2) * BM; mode = 1; }
        else if (pn < 6) { dst = VA; ld = 512; cb = (pn - 4) * BM; mode = 1; }
        else if (pn < 10) { dst = QKB; ld = 1024; cb = (pn - 6) * BM; mode = 2; }
        else if (pn < 12) { dst = VB; ld = 512; cb = (pn - 10) * BM; mode = 3; }
        else if (pn < 14) { dst = SBO; ld = 512; cb = (pn - 12) * BM; mode = 4; }
        else if (pn < 18) { dst = SGA; ld = 1024; cb = (pn - 14) * BM; mode = 4; }
        else { dst = SGB; ld = 1024; cb = (pn - 18) * BM; mode = 4; }
        const int o_p = (pn < 4) ? o_kp : o_vp, o_s = (pn < 4) ? o_ks : o_vs;
        PG8_EPI_WALK({ const int col = cb + cl;
            if (mode == 1) { float* o = out + (row < MPr ? (size_t)o_p + (size_t)row * 512 : (size_t)o_s + (size_t)(row - MPr) * 512) + col; *(f32x4*)o = v0; *(f32x4*)(o + 4) = v1; }
            if (mode == 2) { int j = -1; size_t base = 0;
                if (row < MPr) { const int t = row & 4095; if (t >= 4093) { j = t - 4093; base = (size_t)o_cvp + (size_t)((row >> 12) * 3 + j) * 1024; } }
                else { const int rs = row - MPr, t = rs & 3; if (t >= 1) { j = t - 1; base = (size_t)o_cvs + (size_t)((rs >> 2) * 3 + j) * 1024; } }
                if (j >= 0) { float* o = out + base + col; *(f32x4*)o = v0; *(f32x4*)(o + 4) = v1; } }
            if (mode == 0) { v0 = v0 * qscale; v1 = v1 * qscale; }
            if (mode == 4) { _Pragma("unroll") for (int e = 0; e < 4; ++e) { v0[e] = sigm(v0[e]); v1[e] = sigm(v1[e]); } }
            *(u32x4*)(dst + (size_t)row * ld + col) = pack8(v0, v1); })
    }
};
template <class Epi, class Sched, bool ALIGN_EPI = false, bool SP2 = false>
__device__ __forceinline__ void gemm_phase(PG8_LAS unsigned char* lds, const Gemm g, const Sched& S, const Epi& E) {
    const int tid = threadIdx.x, wid = __builtin_amdgcn_readfirstlane(tid >> 6), lane = tid & 63, wr = wid >> 2, wc = wid & 3, fr = lane & 15, fq = lane >> 4;
    const int K = g.K, nt = K / BK;
    unsigned voffA[2], voffB[2];
#pragma unroll
    for (int i = 0; i < 2; ++i) { int R, C; stage_rc(tid * 16 + i * 8192, R, C); const int Rb = Epi::PERM ? ((R & ~31) + perm32(R & 31)) : R;
        voffA[i] = (unsigned)(R * K + C) * 2u; voffB[i] = (unsigned)(Rb * K + C) * 2u; }
    const size_t kstep = (size_t)(BK * 2);
    const size_t hstep = (size_t)HALF * K * 2;
    const size_t tstep = 2 * hstep;
    const unsigned ldsw = (unsigned)wid * 1024u;
    const int aoff = lds_byte(wr * 64 + fr, fq * 8), boff = lds_byte(wc * 32 + fr, fq * 8);
#define PG8_SA(b, h) (((b) * 2 + (h)) * HTB)
#define PG8_SB(b, h) ((4 + (b) * 2 + (h)) * HTB)
#define PG8_STAGE(bufoff, gbase, voff) do { _Pragma("unroll") for (int _i = 0; _i < 2; ++_i) \
        __builtin_amdgcn_global_load_lds((const unsigned*)((const char*)(gbase) + (voff)[_i]), (PG8_LAS unsigned*)(lds + (bufoff) + ldsw + _i * 8192), 16, 0, 0); } while (0)
#define PG8_LDA(dst, b, h) do { _Pragma("unroll") for (int m = 0; m < 4; ++m) _Pragma("unroll") for (int k = 0; k < 2; ++k) dst[m][k] = *(const PG8_LAS bf16x8*)(lds + PG8_SA(b, h) + aoff + m * 2048 + k * 1024); } while (0)
#define PG8_LDB(dst, b, h) do { _Pragma("unroll") for (int n = 0; n < 2; ++n) _Pragma("unroll") for (int k = 0; k < 2; ++k) dst[n][k] = *(const PG8_LAS bf16x8*)(lds + PG8_SB(b, h) + boff + n * 2048 + k * 1024); } while (0)
#define PG8_MMA(ai, bj, At, Bt) do { __builtin_amdgcn_s_setprio(1); _Pragma("unroll") for (int m = 0; m < 4; ++m) _Pragma("unroll") for (int n = 0; n < 2; ++n) _Pragma("unroll") for (int k = 0; k < 2; ++k) \
        acc[ai][bj][m][n] = __builtin_amdgcn_mfma_f32_16x16x32_bf16(Bt[n][k], At[m][k], acc[ai][bj][m][n], 0, 0, 0); __builtin_amdgcn_s_setprio(0); } while (0)
#define PG8_WAIT_V(n) asm volatile("s_waitcnt vmcnt(" #n ")" ::: "memory")
#define PG8_WAIT_L(n) asm volatile("s_waitcnt lgkmcnt(" #n ")" ::: "memory")
#define PG8_BAR __builtin_amdgcn_s_barrier()
#define PG8_SCHED __builtin_amdgcn_sched_barrier(0)
    Unit cur, nxt; int ui = 0;
    if (!S.next(0, cur)) return;
    f32x4 acc[2][2][4][2];
#pragma unroll
    for (int a = 0; a < 2; ++a)
#pragma unroll
        for (int b = 0; b < 2; ++b)
#pragma unroll
            for (int m = 0; m < 4; ++m)
#pragma unroll
                for (int n = 0; n < 2; ++n) acc[a][b][m][n] = (f32x4){0.f, 0.f, 0.f, 0.f};
    bf16x8 At[4][2], B0[2][2], B1[2][2];
    const char* cA = (const char*)g.A + (size_t)cur.pm * tstep; const char* cB = (const char*)g.Bt + (size_t)cur.pn * tstep;
    S.a_ready(cur);
    if constexpr (SP2) {
        PG8_STAGE(PG8_SB(0, 0), cB, voffB); PG8_STAGE(PG8_SB(0, 1), cB + hstep, voffB); PG8_STAGE(PG8_SA(0, 0), cA, voffA); PG8_STAGE(PG8_SA(0, 1), cA + hstep, voffA);
        if (wr == 1) PG8_BAR;
        PG8_WAIT_V(2); PG8_BAR;
        PG8_STAGE(PG8_SB(1, 0), cB + kstep, voffB); PG8_STAGE(PG8_SA(1, 0), cA + kstep, voffA); PG8_STAGE(PG8_SB(1, 1), cB + hstep + kstep, voffB);
        PG8_WAIT_V(6); PG8_BAR;
    } else {
        PG8_STAGE(PG8_SB(0, 0), cB, voffB); PG8_STAGE(PG8_SA(0, 0), cA, voffA); PG8_STAGE(PG8_SB(0, 1), cB + hstep, voffB); PG8_STAGE(PG8_SA(0, 1), cA + hstep, voffA);
        if (wr == 1) PG8_BAR;
        PG8_WAIT_V(4); PG8_BAR;
        PG8_STAGE(PG8_SB(1, 0), cB + kstep, voffB); PG8_STAGE(PG8_SA(1, 0), cA + kstep, voffA); PG8_STAGE(PG8_SB(1, 1), cB + hstep + kstep, voffB);
        PG8_WAIT_V(6); PG8_BAR;
    }
    for (;;) {
        const bool has_next = S.next(ui + 1, nxt);
        const char* nA = has_next ? (const char*)g.A + (size_t)nxt.pm * tstep : cA; const char* nB = has_next ? (const char*)g.Bt + (size_t)nxt.pn * tstep : cB;
        for (int t = 0; t < nt; t += 2) {
            const bool last = (t == nt - 2);
            const char* a1 = cA + (size_t)(t + 1) * kstep;
            const char* a2 = last ? nA : cA + (size_t)(t + 2) * kstep; const char* b2 = last ? nB : cB + (size_t)(t + 2) * kstep;
            const char* a3 = a2 + kstep; const char* b3 = b2 + kstep;
            if (last && has_next) S.a_ready(nxt);
            if constexpr (SP2) {
            PG8_LDB(B0, 0, 0); PG8_LDB(B1, 0, 1); PG8_SCHED; PG8_LDA(At, 0, 0); PG8_STAGE(PG8_SA(1, 1), a1 + hstep, voffA);
            PG8_WAIT_V(8); PG8_WAIT_L(0); PG8_BAR; PG8_MMA(0, 0, At, B0); PG8_MMA(0, 1, At, B1); PG8_BAR; PG8_SCHED;
            PG8_LDA(At, 0, 1); PG8_STAGE(PG8_SB(0, 0), b2, voffB); PG8_STAGE(PG8_SB(0, 1), b2 + hstep, voffB); PG8_STAGE(PG8_SA(0, 0), a2, voffA);
            PG8_WAIT_V(8); PG8_WAIT_L(0); PG8_BAR; PG8_MMA(1, 0, At, B0); PG8_MMA(1, 1, At, B1); PG8_BAR; PG8_SCHED;
            PG8_LDB(B0, 1, 0); PG8_LDB(B1, 1, 1); PG8_SCHED; PG8_LDA(At, 1, 0); PG8_STAGE(PG8_SA(0, 1), a2 + hstep, voffA);
            PG8_WAIT_V(8); PG8_WAIT_L(0); PG8_BAR; PG8_MMA(0, 0, At, B0); PG8_MMA(0, 1, At, B1); PG8_BAR; PG8_SCHED;
            PG8_LDA(At, 1, 1); PG8_STAGE(PG8_SB(1, 0), b3, voffB); PG8_STAGE(PG8_SB(1, 1), b3 + hstep, voffB); PG8_STAGE(PG8_SA(1, 0), a3, voffA);
            PG8_WAIT_V(8); PG8_WAIT_L(0); PG8_BAR; PG8_MMA(1, 0, At, B0); PG8_MMA(1, 1, At, B1); PG8_BAR; PG8_SCHED;
            } else {
            PG8_LDB(B0, 0, 0); PG8_SCHED; PG8_LDA(At, 0, 0); PG8_STAGE(PG8_SA(1, 1), a1 + hstep, voffA);
            PG8_WAIT_L(8); PG8_BAR; PG8_WAIT_L(0); PG8_MMA(0, 0, At, B0); PG8_BAR; PG8_SCHED;
            PG8_LDB(B1, 0, 1); PG8_STAGE(PG8_SB(0, 0), b2, voffB);
            PG8_BAR; PG8_WAIT_L(0); PG8_MMA(0, 1, At, B1); PG8_BAR;
            PG8_LDA(At, 0, 1); PG8_STAGE(PG8_SA(0, 0), a2, voffA);
            PG8_BAR; PG8_WAIT_L(0); PG8_MMA(1, 0, At, B0); PG8_BAR; PG8_SCHED;
            PG8_STAGE(PG8_SB(0, 1), b2 + hstep, voffB);
            PG8_WAIT_V(6); PG8_BAR; PG8_MMA(1, 1, At, B1); PG8_BAR;
            PG8_LDB(B0, 1, 0); PG8_SCHED; PG8_LDA(At, 1, 0); PG8_STAGE(PG8_SA(0, 1), a2 + hstep, voffA);
            PG8_WAIT_L(8); PG8_BAR; PG8_WAIT_L(0); PG8_MMA(0, 0, At, B0); PG8_BAR; PG8_SCHED;
            PG8_LDB(B1, 1, 1); PG8_STAGE(PG8_SB(1, 0), b3, voffB);
            PG8_BAR; PG8_WAIT_L(0); PG8_MMA(0, 1, At, B1); PG8_BAR;
            PG8_LDA(At, 1, 1); PG8_STAGE(PG8_SA(1, 0), a3, voffA);
            PG8_BAR; PG8_WAIT_L(0); PG8_MMA(1, 0, At, B0); PG8_BAR; PG8_SCHED;
            PG8_STAGE(PG8_SB(1, 1), b3 + hstep, voffB);
            PG8_WAIT_V(6); PG8_BAR; PG8_MMA(1, 1, At, B1); PG8_BAR;
            }
        }
        if constexpr (ALIGN_EPI) { if (wr == 0) PG8_BAR; }
        if constexpr (!Epi::AFTER_DRAIN) { E(acc, cur, wr, wc, fr, fq); S.done(cur); }
        if (!has_next) break;
#pragma unroll
        for (int a = 0; a < 2; ++a)
#pragma unroll
            for (int b = 0; b < 2; ++b)
#pragma unroll
                for (int m = 0; m < 4; ++m)
#pragma unroll
                    for (int n = 0; n < 2; ++n) acc[a][b][m][n] = (f32x4){0.f, 0.f, 0.f, 0.f};
        cur = nxt; cA = nA; cB = nB; ++ui;
        if constexpr (ALIGN_EPI) { if (wr == 1) PG8_BAR; }
    }
    PG8_WAIT_V(0);
    if constexpr (!ALIGN_EPI) { if (wr == 0) PG8_BAR; }
    PG8_BAR;
    if constexpr (Epi::AFTER_DRAIN) { E.fused(acc, cur, wr, wc, fr, fq, lds, wid, lane); S.done(cur); }
#undef PG8_SA
#undef PG8_SB
#undef PG8_STAGE
#undef PG8_LDA
#undef PG8_LDB
#undef PG8_MMA
#undef PG8_WAIT_V
#undef PG8_WAIT_L
#undef PG8_BAR
#undef PG8_SCHED
}
}
#include <hip/hip_bf16.h>
#include <cmath>
namespace attn_body {
using bf16=__hip_bfloat16;
using bf16x8=__attribute__((ext_vector_type(8)))short;
using s16x4=__attribute__((ext_vector_type(4)))short;
using f32x16=__attribute__((ext_vector_type(16)))float;
using u32x4=__attribute__((ext_vector_type(4)))unsigned;
typedef float f32x4_t __attribute__((ext_vector_type(4)));
constexpr int BATCH=4,NHEAD=8,SEQ=4096,D=64,DM=NHEAD*D;
constexpr int NW=8,QBLK=32,QB=QBLK*NW,KVBLK=64,NQB=SEQ/QB;
constexpr int ATTN_PITCH=DM, ATTN_UNIT_ROWS=QB;
__device__ __forceinline__ int crow(int r,int hi){return (r&3)+8*(r>>2)+4*hi;}
#define SBAR() __builtin_amdgcn_sched_barrier(0)
__device__ __forceinline__ void cmask(f32x16&p0,f32x16&p1,int jb,int qrel,int hi){
  const float NEG=-INFINITY; int kb=64*jb+4*hi;
  #pragma unroll
  for(int r=0;r<16;++r){int kv=kb+(r&3)+8*(r>>2); if(kv>qrel)p0[r]=NEG; if(kv+32>qrel)p1[r]=NEG;}
}

constexpr int NSLOT=3, SLOTB=8192;
constexpr int LDS_K=0, LDS_V=NSLOT*SLOTB, LDS_WS=2*NSLOT*SLOTB, LDS_OST=LDS_WS+NW*64*4, LDS_G=LDS_OST+NW*4096, LDS_BYTES=LDS_G+SEQ*4;
constexpr float C2=0.125f*1.4426950408889634f;
__device__ __forceinline__ void glds16(const void*gsrc,unsigned lds_dst){unsigned keep;
  asm volatile("s_mov_b32 %0, m0\n\ts_mov_b32 m0, %2\n\ts_nop 0\n\tglobal_load_lds_dwordx4 %1, off\n\ts_mov_b32 m0, %0":"=&s"(keep):"v"(gsrc),"s"(lds_dst):"memory");}
__device__ __forceinline__ float max3f(float a,float b,float c){float r;asm("v_max3_f32 %0, %1, %2, %3":"=v"(r):"v"(a),"v"(b),"v"(c));return r;}
__device__ __forceinline__ float max2f(float a,float b){float r;asm("v_max_f32_e32 %0, %1, %2":"=v"(r):"v"(a),"v"(b));return r;}
__device__ __forceinline__ float fadd_s(float a,float b){float r;asm("v_add_f32_e32 %0, %1, %2":"=v"(r):"v"(a),"v"(b));return r;}
__device__ __forceinline__ float fsub_s(float a,float b){float r;asm("v_sub_f32_e32 %0, %1, %2":"=v"(r):"v"(a),"v"(b));return r;}
typedef float f32x2_t __attribute__((ext_vector_type(2))); typedef __bf16 bf16x2_t __attribute__((ext_vector_type(2)));
__device__ __forceinline__ unsigned cvtpk_s(float lo,float hi){f32x2_t v={lo,hi};bf16x2_t b=__builtin_convertvector(v,bf16x2_t);return __builtin_bit_cast(unsigned,b);}
#define WAIT_BAR(N) asm volatile("s_waitcnt vmcnt(" #N ") lgkmcnt(0)\n\ts_barrier":::"memory")

__device__ __forceinline__ void qkt(f32x16&p0,f32x16&p1,const char*Kslot,const bf16x8*qr,int r32,int hi){
  const char*kb=Kslot+hi*1024+r32*16;
  #pragma unroll
  for(int d0=0;d0<4;++d0){
    const bf16x8 b0=*reinterpret_cast<const bf16x8*>(kb+d0*2048);
    const bf16x8 b1=*reinterpret_cast<const bf16x8*>(kb+d0*2048+512);
    p0=__builtin_amdgcn_mfma_f32_32x32x16_bf16(b0,qr[d0],p0,0,0,0);p1=__builtin_amdgcn_mfma_f32_32x32x16_bf16(b1,qr[d0],p1,0,0,0);}
}
typedef __attribute__((address_space(3))) const char* lds_cptr;
typedef short v4i16_t __attribute__((ext_vector_type(4)));
__device__ __forceinline__ void kload8(bf16x8*kf,lds_cptr kp){
  kf[0]=*(const __attribute__((address_space(3))) bf16x8*)(kp);      kf[1]=*(const __attribute__((address_space(3))) bf16x8*)(kp+512);
  kf[2]=*(const __attribute__((address_space(3))) bf16x8*)(kp+2048); kf[3]=*(const __attribute__((address_space(3))) bf16x8*)(kp+2560);
  kf[4]=*(const __attribute__((address_space(3))) bf16x8*)(kp+4096); kf[5]=*(const __attribute__((address_space(3))) bf16x8*)(kp+4608);
  kf[6]=*(const __attribute__((address_space(3))) bf16x8*)(kp+6144); kf[7]=*(const __attribute__((address_space(3))) bf16x8*)(kp+6656);
}
__device__ __forceinline__ void kload2(bf16x8*kf,lds_cptr kp,int j){ kf[2*j]=*(const __attribute__((address_space(3))) bf16x8*)(kp+j*2048); kf[2*j+1]=*(const __attribute__((address_space(3))) bf16x8*)(kp+j*2048+512); }
__device__ __forceinline__ s16x4 vtr(lds_cptr p){ return __builtin_bit_cast(s16x4,__builtin_amdgcn_ds_read_tr16_b64_v4i16((__attribute__((address_space(3))) v4i16_t*)p)); }
__device__ __forceinline__ float rowmax(const f32x16&p0,const f32x16&p1){
  float a=max3f(p0[0],p0[1],p1[0]),b=max3f(p0[2],p0[3],p1[1]);a=max3f(a,p1[2],p1[3]);
  #pragma unroll
  for(int r=4;r<16;r+=4){a=max3f(a,p0[r],p0[r+1]);b=max3f(b,p0[r+2],p0[r+3]);a=max3f(a,p1[r],p1[r+1]);b=max3f(b,p1[r+2],p1[r+3]);}
  const float m=max2f(a,b);
  auto rr=__builtin_amdgcn_permlane32_swap(__float_as_uint(m),__float_as_uint(m),false,false);
  return max2f(__uint_as_float(rr[0]),__uint_as_float(rr[1]));
}
__device__ __forceinline__ void pv(f32x16*o,int vb,bf16x8 pa0,bf16x8 pa1,bf16x8 pa2,bf16x8 pa3){
  #pragma unroll
  for(int d0=0;d0<2;++d0){s16x4 lo[4],hi[4];
    #pragma unroll
    for(int ks=0;ks<4;++ks){
      asm volatile("ds_read_b64_tr_b16 %0,%1 offset:%c2":"=&v"(lo[ks]):"v"(vb),"i"(d0*4096+ks*1024):"memory");
      asm volatile("ds_read_b64_tr_b16 %0,%1 offset:%c2":"=&v"(hi[ks]):"v"(vb),"i"(d0*4096+ks*1024+512):"memory");}
    asm volatile("s_waitcnt lgkmcnt(0)":::"memory");SBAR();
    #define PK(k) (bf16x8){lo[k][0],lo[k][1],lo[k][2],lo[k][3],hi[k][0],hi[k][1],hi[k][2],hi[k][3]}
    o[d0]=__builtin_amdgcn_mfma_f32_32x32x16_bf16(pa0,PK(0),o[d0],0,0,0);
    o[d0]=__builtin_amdgcn_mfma_f32_32x32x16_bf16(pa1,PK(1),o[d0],0,0,0);
    o[d0]=__builtin_amdgcn_mfma_f32_32x32x16_bf16(pa2,PK(2),o[d0],0,0,0);
    o[d0]=__builtin_amdgcn_mfma_f32_32x32x16_bf16(pa3,PK(3),o[d0],0,0,0);
    #undef PK
  }
}

#ifndef ATTN_STORE16
#define ATTN_STORE16(p,v) (*(u32x4*)(p)=(v))
#endif
template<int THRL> __device__ __forceinline__ void attn_unit(int b,int h,int qb,const bf16*Q,const bf16*__restrict__ K,const bf16*__restrict__ V,bf16*O,const float*__restrict__ Gn,char*shm){
  const int tid=threadIdx.x,lane=tid&63,r32=lane&31,hi=lane>>5; const int wid=__builtin_amdgcn_readfirstlane(tid>>6);
  const long rowbase=(long)b*SEQ; const int q0=qb*QB;
  const bf16*Qw=Q+(rowbase+q0+wid*QBLK)*DM+h*D;
  const bf16*Kh=K+rowbase*DM+h*D,*Vh=V+rowbase*DM+h*D;
  const lds_cptr shm3=(lds_cptr)shm;
  const unsigned lds0=(unsigned)(uintptr_t)shm;
  float*wsf=(float*)(shm+LDS_WS)+wid*64;
  const bf16*ksrc=Kh+(long)lane*DM+wid*8;
  const bf16*vsrc=Vh+(long)(16*(wid&3)+(lane>>2))*DM+(wid>>2)*32+(lane&3)*8;
  const unsigned kdst=lds0+LDS_K+wid*1024, vdst=lds0+LDS_V+wid*1024;
  #define DMA_K(t,slot) glds16(ksrc+(long)(t)*KVBLK*DM,(unsigned)__builtin_amdgcn_readfirstlane(kdst+(slot)))
  #define DMA_V(t,slot) glds16(vsrc+(long)(t)*KVBLK*DM,(unsigned)__builtin_amdgcn_readfirstlane(vdst+(slot)))
  const int vb0=(int)(lds0+LDS_V)+((lane>>4)&1)*32+(lane&3)*8+(4*hi+((lane&15)>>2))*64;
  const char*Kbase=shm+LDS_K; bf16x8 kf[8];
  const lds_cptr kp0=shm3+LDS_K+hi*1024+r32*16; const lds_cptr vp0=shm3+LDS_V+((lane>>4)&1)*32+(lane&3)*8+(4*hi+((lane&15)>>2))*64;
  const int NT=(q0+QB)/KVBLK;
  typedef __attribute__((address_space(3))) float* lds_fptr; typedef __attribute__((address_space(3))) const f32x4_t* lds_f4cptr;
  { const f32x4_t* gsrc4=(const f32x4_t*)(Gn+(long)(b*NHEAD+h)*SEQ); __attribute__((address_space(3))) f32x4_t* gdst4=(__attribute__((address_space(3))) f32x4_t*)(shm3+LDS_G);
    for(int i_=tid;i_<(q0+QB)/4;i_+=NW*64) gdst4[i_]=gsrc4[i_]; }
  const __attribute__((address_space(3))) float* gl0=(const __attribute__((address_space(3))) float*)(shm3+LDS_G)+4*hi;
  #define CINIT(C0,C1,t_) do{ const __attribute__((address_space(3))) float* gp_=gl0+(t_)*KVBLK; \
    _Pragma("unroll") for(int g_=0;g_<4;++g_){ const f32x4_t a_=*(lds_f4cptr)(gp_+8*g_); const f32x4_t b_=*(lds_f4cptr)(gp_+32+8*g_); \
      C0[4*g_+0]=nm+a_[0];C0[4*g_+1]=nm+a_[1];C0[4*g_+2]=nm+a_[2];C0[4*g_+3]=nm+a_[3]; C1[4*g_+0]=nm+b_[0];C1[4*g_+1]=nm+b_[1];C1[4*g_+2]=nm+b_[2];C1[4*g_+3]=nm+b_[3]; } }while(0)
  DMA_K(0,0);DMA_V(0,0);DMA_K(1,SLOTB);
  bf16x8 qr[4];
  #pragma unroll
  for(int d0=0;d0<4;++d0)qr[d0]=*reinterpret_cast<const bf16x8*>(&Qw[(long)r32*DM+d0*16+hi*8]);
  float mhat=0.f,l_reg=0.f,nm=0.f;f32x16 o[2];o[0]=f32x16{};o[1]=f32x16{};
  const int qrel=wid*QBLK+r32;
  #define CMASK(P0,P1,t) do{int jb_=(t)-(NT-4); if(jb_>=0)cmask(P0,P1,jb_,qrel,hi);}while(0)
  bool resc=false;
  #define START(P0,P1) do{ const float rm=rowmax(P0,P1); resc=false; \
    { const float dl=rm; mhat=fadd_s(mhat,dl); \
      _Pragma("unroll") for(int r=0;r<16;++r){P0[r]=fsub_s(P0[r],dl);P1[r]=fsub_s(P1[r],dl);} \
      nm=-mhat; } \
    _Pragma("unroll") for(int r=0;r<16;++r)P0[r]=__builtin_amdgcn_exp2f(P0[r]); }while(0)
  #define RESC() do{ if(resc){ asm volatile("s_waitcnt lgkmcnt(0)":::"memory"); \
      _Pragma("unroll") for(int d_=0;d_<2;++d_) _Pragma("unroll") for(int r=0;r<16;++r)o[d_][r]*=wsf[crow(r,hi)]; } }while(0)
  f32x16 pA0,pA1,pB0,pB1;
  int sl_prev=0,sl_cur=0,sl_next=SLOTB;
  #define ROT() do{sl_prev=sl_cur;sl_cur=sl_next;sl_next=(sl_next==(NSLOT-1)*SLOTB)?0:sl_next+SLOTB;}while(0)
  DMA_K(2,2*SLOTB);
  WAIT_BAR(3);
  CINIT(pA0,pA1,0); qkt(pA0,pA1,Kbase,qr,r32,hi);asm volatile("s_nop 15\n\ts_nop 7":"+v"(pA0),"+v"(pA1));CMASK(pA0,pA1,0);
  START(pA0,pA1);
  _Pragma("unroll") for(int r=0;r<16;++r)pA1[r]=__builtin_amdgcn_exp2f(pA1[r]);
  WAIT_BAR(0);
  DMA_K(3,0);DMA_V(1,SLOTB);
  ROT();
  kload8(kf,kp0+sl_cur);
  WAIT_BAR(2);
  s16x4 vlo[8],vhi[8]; u32x4 pw0,pw1,pw2,pw3;
  #define PKW(P,B) cvtpk_s(P[B],P[B+1])
  #define PAF(k) __builtin_bit_cast(bf16x8,pw##k)
  #define VFR(i) (bf16x8){vlo[i][0],vlo[i][1],vlo[i][2],vlo[i][3],vhi[i][0],vhi[i][1],vhi[i][2],vhi[i][3]}
  #define PIN(x) asm volatile("":"+v"(x))
  #define MX3(a,b,c) __builtin_fmaxf(__builtin_fmaxf((a),(b)),(c))
  #define GAPA(MF,A0,A1,A2,A3,W0,W1,PW) do{ MF; sacc+=A0; sacc+=A1; sacc+=A2; sacc+=A3; PIN(sacc); W0; W1; PIN(PW); SBAR(); }while(0)
  #define EX(v) __builtin_amdgcn_exp2f(v)
  #define GAPB(MF,X,B) do{ MF; X[B]=EX(X[B]); X[B+1]=EX(X[B+1]); X[B+2]=EX(X[B+2]); X[B+3]=EX(X[B+3]); PIN(X); SBAR(); }while(0)
  #define VRD(i) do{ vlo[i]=vtr(vp_+(((i)>>2)*4096+((i)&3)*1024)); vhi[i]=vtr(vp_+(((i)>>2)*4096+((i)&3)*1024+512)); }while(0)
  #define KRD(G,j) do{ if(G){ kload2(kf,kp0+sl_next,j); SBAR(); } }while(0)
  #define STEP(C0,C1,P0,P1,t,GK,GV,GL) do{ SBAR(); \
    const lds_cptr vp_=vp0+sl_prev; \
    CINIT(C0,C1,t); SBAR(); \
    VRD(0); SBAR(); float sacc=(P0[0]+P0[1]); \
    GAPA(C0=__builtin_amdgcn_mfma_f32_32x32x16_bf16(kf[0],qr[0],C0,0,0,0), P0[2],P0[3],P0[4],P0[5],     pw0[0]=PKW(P0,0), pw0[1]=PKW(P0,2), pw0); \
    VRD(4); SBAR(); GAPA(C1=__builtin_amdgcn_mfma_f32_32x32x16_bf16(kf[1],qr[0],C1,0,0,0), P0[6],P0[7],P0[8],P0[9],     pw0[2]=PKW(P0,4), pw0[3]=PKW(P0,6), pw0); \
    VRD(1); SBAR(); GAPA(C0=__builtin_amdgcn_mfma_f32_32x32x16_bf16(kf[2],qr[1],C0,0,0,0),   P0[10],P0[11],P0[12],P0[13], pw1[0]=PKW(P0,8), pw1[1]=PKW(P0,10), pw1); \
    VRD(5); SBAR(); GAPA(C1=__builtin_amdgcn_mfma_f32_32x32x16_bf16(kf[3],qr[1],C1,0,0,0),   P0[14],P0[15],P1[0],P1[1],   pw1[2]=PKW(P0,12),pw1[3]=PKW(P0,14), pw1); \
    VRD(2); SBAR(); GAPA(C0=__builtin_amdgcn_mfma_f32_32x32x16_bf16(kf[4],qr[2],C0,0,0,0),   P1[2],P1[3],P1[4],P1[5],     pw2[0]=PKW(P1,0), pw2[1]=PKW(P1,2), pw2); \
    VRD(6); SBAR(); GAPA(C1=__builtin_amdgcn_mfma_f32_32x32x16_bf16(kf[5],qr[2],C1,0,0,0),   P1[6],P1[7],P1[8],P1[9],     pw2[2]=PKW(P1,4), pw2[3]=PKW(P1,6), pw2); \
    VRD(3); SBAR(); GAPA(C0=__builtin_amdgcn_mfma_f32_32x32x16_bf16(kf[6],qr[3],C0,0,0,0),   P1[10],P1[11],P1[12],P1[13], pw3[0]=PKW(P1,8), pw3[1]=PKW(P1,10), pw3); \
    VRD(7); SBAR(); GAPA(C1=__builtin_amdgcn_mfma_f32_32x32x16_bf16(kf[7],qr[3],C1,0,0,0),   P1[14],P1[15],0.f,0.f,       pw3[2]=PKW(P1,12),pw3[3]=PKW(P1,14), pw3); \
    l_reg+=sacc; \
    if(GK){DMA_K((t)+3,sl_cur);} if(GV){DMA_V((t)+1,sl_next);} \
    CMASK(C0,C1,t); \
    { float a=MX3(C0[0],C0[1],C1[0]),b=MX3(C0[2],C0[3],C1[1]); a=MX3(a,C1[2],C1[3]); \
      _Pragma("unroll") for(int r=4;r<16;r+=4){a=MX3(a,C0[r],C0[r+1]);b=MX3(b,C0[r+2],C0[r+3]);a=MX3(a,C1[r],C1[r+1]);b=MX3(b,C1[r+2],C1[r+3]);} \
      float rm=__builtin_fmaxf(a,b); { auto rr=__builtin_amdgcn_permlane32_swap(__float_as_uint(rm),__float_as_uint(rm),false,false); rm=__builtin_fmaxf(__uint_as_float(rr[0]),__uint_as_float(rr[1])); } \
      resc=false; \
      if(__builtin_expect(__any(rm>(float)THRL),0)){ const float dl=__builtin_fmaxf(rm,0.f); mhat+=dl; \
        _Pragma("unroll") for(int r=0;r<16;++r){C0[r]-=dl;C1[r]-=dl;} \
        nm=-mhat; \
        const float f=__builtin_amdgcn_exp2f(-dl); l_reg*=f; if(hi==0)wsf[r32]=f; resc=true; } } \
    SBAR(); \
    GAPB(o[0]=__builtin_amdgcn_mfma_f32_32x32x16_bf16(PAF(0),VFR(0),o[0],0,0,0), C0,0); \
    GAPB(o[1]=__builtin_amdgcn_mfma_f32_32x32x16_bf16(PAF(0),VFR(4),o[1],0,0,0), C0,4); \
    KRD(GL,0); GAPB(o[0]=__builtin_amdgcn_mfma_f32_32x32x16_bf16(PAF(1),VFR(1),o[0],0,0,0), C0,8); \
    KRD(GL,1); GAPB(o[1]=__builtin_amdgcn_mfma_f32_32x32x16_bf16(PAF(1),VFR(5),o[1],0,0,0), C0,12); \
    KRD(GL,2); GAPB(o[0]=__builtin_amdgcn_mfma_f32_32x32x16_bf16(PAF(2),VFR(2),o[0],0,0,0), C1,0); \
    KRD(GL,3); GAPB(o[1]=__builtin_amdgcn_mfma_f32_32x32x16_bf16(PAF(2),VFR(6),o[1],0,0,0), C1,4); \
    GAPB(o[0]=__builtin_amdgcn_mfma_f32_32x32x16_bf16(PAF(3),VFR(3),o[0],0,0,0), C1,8); \
    GAPB(o[1]=__builtin_amdgcn_mfma_f32_32x32x16_bf16(PAF(3),VFR(7),o[1],0,0,0), C1,12); \
    }while(0)
  int t=1;
  #undef CMASK
  #define CMASK(P0,P1,t) do{}while(0)
  for(;t+5<NT;t+=2){
    STEP(pB0,pB1,pA0,pA1,t,true,true,true);     WAIT_BAR(2); RESC(); ROT();
    STEP(pA0,pA1,pB0,pB1,t+1,true,true,true);   WAIT_BAR(2); RESC(); ROT();
  }
  #undef CMASK
  #define CMASK(P0,P1,t) do{int jb_=(t)-(NT-4); if(jb_>=0)cmask(P0,P1,jb_,qrel,hi);}while(0)
  #define ENDW(tt) do{ if((tt)+3<NT){WAIT_BAR(2);} else if((tt)+2<NT){WAIT_BAR(1);} else {WAIT_BAR(0);} }while(0)
  for(;t+1<NT;t+=2){
    STEP(pB0,pB1,pA0,pA1,t,(t+3<NT),(t+1<NT),(t+1<NT));       ENDW(t);   RESC(); ROT();
    STEP(pA0,pA1,pB0,pB1,t+1,(t+4<NT),(t+2<NT),(t+2<NT));     ENDW(t+1); RESC(); ROT();
  }
  STEP(pB0,pB1,pA0,pA1,NT-1,false,false,false); RESC();
  { float sacc=pB0[0]+pB0[1]; _Pragma("unroll") for(int r=2;r<16;++r)sacc+=pB0[r]; _Pragma("unroll") for(int r=0;r<16;++r)sacc+=pB1[r]; l_reg+=sacc;
    pw0=(u32x4){PKW(pB0,0),PKW(pB0,2),PKW(pB0,4),PKW(pB0,6)};pw1=(u32x4){PKW(pB0,8),PKW(pB0,10),PKW(pB0,12),PKW(pB0,14)};pw2=(u32x4){PKW(pB1,0),PKW(pB1,2),PKW(pB1,4),PKW(pB1,6)};pw3=(u32x4){PKW(pB1,8),PKW(pB1,10),PKW(pB1,12),PKW(pB1,14)};
    SBAR(); pv(o,vb0+sl_cur,PAF(0),PAF(1),PAF(2),PAF(3)); }
  #undef PKW
  #undef PAF
  #undef VFR
  #undef PIN
  #undef MX3
  #undef GAPA
  #undef GAPB
  #undef EX
  #undef VRD
  #undef KRD
  #undef STEP
  #undef ENDW
  {auto rr=__builtin_amdgcn_permlane32_swap(__float_as_uint(l_reg),__float_as_uint(l_reg),false,false);l_reg=__uint_as_float(rr[0])+__uint_as_float(rr[1]);}
  if(hi==0)wsf[32+r32]=l_reg;asm volatile("s_waitcnt lgkmcnt(0)":::"memory");
  float rli[16];
  #pragma unroll
  for(int r=0;r<16;++r)rli[r]=__builtin_amdgcn_rcpf(wsf[32+crow(r,hi)]);
  bf16*Ow=O+(rowbase+q0+wid*QBLK)*DM+h*D;
  { bf16*stg=(bf16*)(shm+LDS_OST)+wid*2048;
    #pragma unroll
    for(int r=0;r<16;++r){const int orow=crow(r,hi);
      #pragma unroll
      for(int d0=0;d0<2;++d0)stg[orow*64+d0*32+r32]=__float2bfloat16(o[d0][r]*rli[r]);}
    asm volatile("s_waitcnt lgkmcnt(0)":::"memory");
    #pragma unroll
    for(int i=0;i<4;++i){const int row=i*8+(lane>>3),ch=lane&7; const u32x4 v=*(const u32x4*)(stg+row*64+ch*8); ATTN_STORE16(Ow+(long)row*DM+ch*8,v);} }
  asm volatile("s_waitcnt lgkmcnt(0)\n\ts_barrier":::"memory");
  #undef DMA_K
  #undef DMA_V
  #undef CMASK
  #undef START
  #undef RESC
  #undef ROT
  #undef CINIT
}
constexpr int ATTN_LDS_BYTES=LDS_BYTES;
struct AttnTensors { const bf16* Q; const bf16* K; const bf16* V; bf16* O; const float* Gn; };
struct AttnUnit { int bh; int qb; };
struct StaticOrder {
  int vcu, G;
  __device__ __forceinline__ explicit StaticOrder(int grid,int vcu_):vcu(vcu_),G(grid){}
  __device__ __forceinline__ bool next(int i,AttnUnit&u)const{ const int v=vcu+(i>>1)*G; if(v>=BATCH*NHEAD*8)return false; const int s=v&7; u.bh=v>>3; u.qb=(i&1)?15-s:s; return true; }
  __device__ __forceinline__ void a_ready(const AttnUnit&)const{}
  __device__ __forceinline__ void done(const AttnUnit&)const{}
};
template<class Sched,int THRL=8> __device__ __forceinline__ void attn_phase(char*lds,const AttnTensors&T,const Sched&S){
  AttnUnit u;
  for(int i=0;S.next(i,u);++i){ S.a_ready(u); attn_unit<THRL>(u.bh/NHEAD,u.bh%NHEAD,u.qb,T.Q,T.K,T.V,T.O,T.Gn,lds); S.done(u); }
}
#undef SBAR
#undef WAIT_BAR
}
#define GAS __attribute__((address_space(1)))
#define LAS __attribute__((address_space(3)))
typedef unsigned short bf16;
typedef unsigned v4u __attribute__((ext_vector_type(4)));
typedef float f32x4 __attribute__((ext_vector_type(4)));
typedef short bf16x8 __attribute__((ext_vector_type(8)));
typedef GAS unsigned gu32;
typedef GAS unsigned long long gu64;
#define RLX_AGENT __ATOMIC_RELAXED, __HIP_MEMORY_SCOPE_AGENT
#define LDS_WAIT() asm volatile("s_waitcnt lgkmcnt(0)" ::: "memory")
#define VM_WAIT() asm volatile("s_waitcnt vmcnt(0)" ::: "memory")
__device__ __forceinline__ unsigned long long rt() { return __builtin_amdgcn_s_memrealtime(); }
__device__ __forceinline__ unsigned f2bf(float f) { unsigned u = __builtin_bit_cast(unsigned, f); return (u + 0x7fffu + ((u >> 16) & 1u)) >> 16; }
__device__ __forceinline__ unsigned pk2(float lo, float hi) { return f2bf(lo) | (f2bf(hi) << 16); }

#define XB_TMO      128
#define XB_XCNT(j)  (256  + 64 * (j))
#define XB_XSUB(j)  (1280 + 64 * (j))
#define XB_XGEN(j)  (2304 + 64 * (j))
#define XB_TOP      3328
#define XB_TOPGEN   3392
#define XCD_BAR_WORDS 3456
#define XB_SPIN_CAP (1u << 18)

__device__ __forceinline__ unsigned xb_ld(unsigned* p)              { return __hip_atomic_load(p, __ATOMIC_RELAXED, __HIP_MEMORY_SCOPE_AGENT); }
__device__ __forceinline__ unsigned xb_add(unsigned* p, unsigned v) { return __hip_atomic_fetch_add(p, v, __ATOMIC_RELAXED, __HIP_MEMORY_SCOPE_AGENT); }
__device__ __forceinline__ unsigned xb_xcc_id() { return (unsigned)__builtin_amdgcn_s_getreg((3 << 11) | 20) & 0xFu; }
#define XB_SPIN(cond, bar) do { unsigned _sp = 0; while (cond) { __builtin_amdgcn_s_sleep(1); \
    if ((++_sp & 255u) == 0u) { if (xb_ld(&(bar)[XB_TMO])) break; if (_sp > XB_SPIN_CAP) { atomicAdd(&(bar)[XB_TMO], 1u); break; } } } } while (0)

struct XcdBarrier {
    unsigned* bar; unsigned x;
    volatile LAS unsigned* st;
};

__device__ __forceinline__ XcdBarrier xcd_barrier_post(unsigned* bar, volatile LAS unsigned* st) {
    XcdBarrier b; b.bar = bar; b.x = xb_xcc_id(); b.st = st;
    if (threadIdx.x == 0) (void)xb_add(&bar[XB_XCNT(b.x)], 1u);
    return b;
}
__device__ __forceinline__ void xcd_barrier_complete(unsigned* bar, unsigned x, unsigned& nloc, unsigned& nx) {
    const unsigned G = gridDim.x * gridDim.y * gridDim.z;
    unsigned sum, cnt, mine, sp = 0u;
    for (;;) {
        sum = 0u; cnt = 0u; mine = 0u;
#pragma unroll
        for (unsigned j = 0; j < 16; ++j) { const unsigned c = xb_ld(&bar[XB_XCNT(j)]); sum += c; cnt += (c > 0u) ? 1u : 0u; mine = (j == x) ? c : mine; }
        if (sum == G) break;
        __builtin_amdgcn_s_sleep(1);
        if ((++sp & 255u) == 0u) { if (xb_ld(&bar[XB_TMO])) break; if (sp > XB_SPIN_CAP) { atomicAdd(&bar[XB_TMO], 1u); break; } }
    }
    nloc = mine > 0u ? mine : 1u; nx = cnt > 0u ? cnt : 1u;
}

__device__ __forceinline__ void xcd_barrier(const XcdBarrier& b) {
    asm volatile("s_waitcnt vmcnt(0)" ::: "memory");
    __syncthreads();
    if (threadIdx.x == 0) {
        unsigned* bar = b.bar;
        __builtin_amdgcn_s_waitcnt(0);
        unsigned nloc = b.st[0], nx = b.st[1];
        if (nloc == 0u) { xcd_barrier_complete(bar, b.x, nloc, nx); b.st[0] = nloc; b.st[1] = nx; }
        const unsigned old = xb_add(&bar[XB_XSUB(b.x)], 1u);
        const unsigned gen = old / nloc;
        if (old + 1u == (gen + 1u) * nloc) {
            __builtin_amdgcn_fence(__ATOMIC_RELEASE, "agent");
            asm volatile("s_waitcnt vmcnt(0)" ::: "memory");
            const unsigned og = xb_add(&bar[XB_TOP], 1u);
            const unsigned tg = og / nx;
            if (og + 1u == (tg + 1u) * nx) xb_add(&bar[XB_TOPGEN], 1u);
            else XB_SPIN(xb_ld(&bar[XB_TOPGEN]) == tg, bar);
            __builtin_amdgcn_fence(__ATOMIC_ACQUIRE, "agent");
            xb_add(&bar[XB_XGEN(b.x)], 1u);
            asm volatile("s_waitcnt vmcnt(0)" ::: "memory");
        } else {
            XB_SPIN(xb_ld(&bar[XB_XGEN(b.x)]) == gen, bar);
            __builtin_amdgcn_fence(__ATOMIC_ACQUIRE, "agent");
            asm volatile("s_waitcnt vmcnt(0)" ::: "memory");
        }
    }
    __syncthreads();
}
constexpr int NWAVES = 8;
#ifndef MK_N_LAUNCHES
#define MK_N_LAUNCHES 1
#endif
constexpr int NPH = 13;
constexpr bool ONE_LAUNCH = (MK_N_LAUNCHES == 1);

constexpr int D = 1024, MP = 16384, MS = 512, M = MP + MS, SEQ = 4096, NB = 4, DB = 128, DSEQ = 4;
constexpr int AH = 8, AW = 512, BHN = 4, BHD = 128, BW = 512, FF = 4096, NIN = 5648, NINP = 5888, NMODC = 6144;
constexpr int NPAGES = 16, PAGE = 128;
constexpr float RMS_EPS = 1e-6f, LOG2E = 1.4426950408889634f;
constexpr int O_Y = 0;
constexpr int O_KP = O_Y + M * D, O_VP = O_KP + MP * AW, O_LFP = O_VP + MP * AW, O_CP = O_LFP + MP * AH, O_NP = O_CP + NB * BHN * BHD * BHD, O_MP = O_NP + NB * BHN * BHD,
              O_CVP = O_MP + NB * BHN, O_KS = O_CVP + NB * 3 * 1024, O_VS = O_KS + MS * AW, O_LFS = O_VS + MS * AW, O_CS = O_LFS + MS * AH, O_NS = O_CS + DB * BHN * BHD * BHD,
              O_MS = O_NS + DB * BHN * BHD, O_CVS = O_MS + DB * BHN, O_END = O_CVS + DB * 3 * 1024;
static_assert(O_END == 43862544, "output size");

constexpr size_t MiB = 1u << 20;
constexpr size_t WS_CTL = 0, CTL_ZERO_BYTES = 1 * MiB;
constexpr size_t WS_WIN = 2 * MiB, WS_WPA = 14 * MiB, WS_WPB = 15 * MiB, WS_WOUT = 16 * MiB, WS_WUP = 18 * MiB, WS_WDN = 26 * MiB, WS_WADA = 34 * MiB, WS_SC = 46 * MiB, WS_MOD = 47 * MiB;
constexpr size_t WS_XN = 54 * MiB, WS_QA = 88 * MiB, WS_KA = 105 * MiB, WS_VA = 122 * MiB, WS_QKB = 139 * MiB, WS_VB = 172 * MiB, WS_SBO = 189 * MiB, WS_SGA = 206 * MiB, WS_SGB = 239 * MiB;
constexpr size_t WS_LFA = 272 * MiB, WS_IPRE = 273 * MiB, WS_LFB = 274 * MiB, WS_GN = 275 * MiB, WS_OA = 276 * MiB, WS_HB = 293 * MiB, WS_MQ = 310 * MiB, WS_MK = 327 * MiB;
constexpr size_t WS_KVT = 344 * MiB, WS_KN = 408 * MiB, WS_BLML = 409 * MiB, WS_CST = 410 * MiB, WS_NST = 442 * MiB, WS_MST = 443 * MiB;
constexpr size_t WS_T1 = 444 * MiB, WS_T = 510 * MiB, WS_Y = 544 * MiB, WS_U = 610 * MiB, WS_PART = 742 * MiB, WS_END = 760 * MiB;
static_assert(WS_WIN + (size_t)NINP * D * 2 <= WS_WPA && WS_WADA + (size_t)NMODC * D * 2 <= WS_SC && WS_MOD + 256 * (size_t)NMODC * 4 <= WS_XN && WS_XN + (size_t)M * D * 2 <= WS_QA, "ws map 1");
static_assert(WS_QA + (size_t)M * 512 * 2 <= WS_KA && WS_QKB + (size_t)M * 1024 * 2 <= WS_VB && WS_SGA + (size_t)M * 1024 * 2 <= WS_SGB && WS_SGB + (size_t)M * 1024 * 2 <= WS_LFA, "ws map 2");
static_assert(WS_KVT + 1024 * (size_t)65536 <= WS_KN && WS_CST + 1024 * (size_t)32768 <= WS_NST && WS_T1 + (size_t)M * D * 4 <= WS_T && WS_T + (size_t)M * D * 2 <= WS_Y && WS_Y + (size_t)M * D * 4 <= WS_U, "ws map 3");
static_assert(WS_U + (size_t)M * FF * 2 <= WS_PART && WS_PART + (size_t)DB * NPAGES * AH * 4 * 68 * 4 <= WS_END, "ws map 4");
constexpr int CW_TMO = 0, CW_CODE = 1, CW_BAR = 4096;
constexpr int PART_STRIDE = 68;

constexpr int RING_OFF = 0, RING_BYTES = 131072;
constexpr int LDSCTL_OFF = RING_BYTES, MISC_OFF = LDSCTL_OFF + 320;
constexpr int LDS_BYTES = 147456;
static_assert(MISC_OFF + 128 <= LDS_BYTES, "LDS map");
struct Ctx {
    LAS unsigned char* lds; gu32* ctl; int tid, lane, wave, vcu, G;
    const float *x_prompt, *x_sample, *cache_k, *cache_v, *cache_logf; const int* page_table;
    const float *state_C, *state_n, *state_m, *state_conv, *c_prompt, *c_sample, *w_ada, *b_ada, *g_pre_mix, *g_post_mix, *g_pre_mlp, *g_post_mlp,
                *w_in, *b_fox_f, *b_ml_i, *b_ml_f, *conv_w, *conv_b, *w_proj_a, *w_proj_b, *w_out, *w_up, *w_down;
    float* out; unsigned char* ws;
};
typedef short s16x4v __attribute__((ext_vector_type(4)));
typedef unsigned short u16x8 __attribute__((ext_vector_type(8)));
typedef unsigned short u16x4 __attribute__((ext_vector_type(4)));
typedef unsigned u32x2 __attribute__((ext_vector_type(2)));
#define MFMA16(a, b, c) __builtin_amdgcn_mfma_f32_16x16x32_bf16((a), (b), (c), 0, 0, 0)
__device__ __forceinline__ float bf2f(unsigned short b) { return __uint_as_float(((unsigned)b) << 16); }
__device__ __forceinline__ float sigm(float x) { return 1.0f / (1.0f + __expf(-x)); }
__device__ __forceinline__ float siluf(float x) { return x / (1.0f + __expf(-x)); }
__device__ __forceinline__ float wave_sum(float v) {
#pragma unroll
    for (int o = 1; o < 64; o <<= 1) v += __shfl_xor(v, o);
    return v;
}
__device__ __forceinline__ float wave_max(float v) {
#pragma unroll
    for (int o = 1; o < 64; o <<= 1) v = fmaxf(v, __shfl_xor(v, o));
    return v;
}
__device__ __forceinline__ float wave_scan_add(float v, int lane) {
#pragma unroll
    for (int o = 1; o < 64; o <<= 1) { const float t = __shfl_up(v, o); if (lane >= o) v += t; }
    return v;
}
__device__ __forceinline__ float wave_scan_max(float v, int lane) {
#pragma unroll
    for (int o = 1; o < 64; o <<= 1) { const float t = __shfl_up(v, o); if (lane >= o) v = fmaxf(v, t); }
    return v;
}

__device__ __forceinline__ void tr_item(const float* W, int ldw, int k0, int c0, bf16* WT, int ldt, int r0, LAS float* scr, int lane, bool gate) {
    const int n_ = lane & 31;
#pragma unroll 8
    for (int i = 0; i < 32; ++i) { const int kk = 2 * i + (lane >> 5);
        float v;
        if (gate) { const int sc = n_ < 8 ? 1536 + n_ : 3072 + n_; v = n_ < 16 ? W[(size_t)(k0 + kk) * ldw + sc] : 0.f; }
        else v = W[(size_t)(k0 + kk) * ldw + c0 + n_];
        scr[kk * 33 + n_] = v; }
    LDS_WAIT(); asm volatile("" ::: "memory");
    const int c = lane & 7;
#pragma unroll
    for (int j = 0; j < 4; ++j) { const int n = (lane >> 3) + 8 * j; const LAS float* s = scr + (8 * c) * 33 + n;
        v4u o; o.x = pk2(s[0 * 33], s[1 * 33]); o.y = pk2(s[2 * 33], s[3 * 33]); o.z = pk2(s[4 * 33], s[5 * 33]); o.w = pk2(s[6 * 33], s[7 * 33]);
        *(GAS v4u*)(WT + (size_t)(r0 + n) * ldt + k0 + 8 * c) = o; }
    LDS_WAIT(); asm volatile("" ::: "memory");
}
__device__ __forceinline__ void p0_prologue(const Ctx& C) {
    LAS float* scr = (LAS float*)(C.lds + RING_OFF + C.wave * 16384);
    const int gw = C.vcu * NWAVES + C.wave, NGW = C.G * NWAVES, lane = C.lane;
    bf16* WIN = (bf16*)(C.ws + WS_WIN); bf16* WPA = (bf16*)(C.ws + WS_WPA); bf16* WPB = (bf16*)(C.ws + WS_WPB); bf16* WOUT = (bf16*)(C.ws + WS_WOUT);
    bf16* WUP = (bf16*)(C.ws + WS_WUP); bf16* WDN = (bf16*)(C.ws + WS_WDN); bf16* WADA = (bf16*)(C.ws + WS_WADA); bf16* SC = (bf16*)(C.ws + WS_SC);
    constexpr int I_IN = 16 * 176, I_G = 16, I_PA = 8 * 32, I_PB = 8 * 32, I_OUT = 16 * 32, I_UP = 16 * 128, I_DN = 64 * 32, I_ADA = 16 * 192;
    constexpr int NITEMS = I_IN + I_G + I_PA + I_PB + I_OUT + I_UP + I_DN + I_ADA;
    for (int it = gw; it < NITEMS; it += NGW) {
        int r = it;
        if (r < I_IN) { const int kb = r / 176, nb = r % 176, n0 = 32 * nb, c0 = n0 + (n0 >= 3072 ? 16 : (n0 >= 1536 ? 8 : 0)); tr_item(C.w_in, NIN, 64 * kb, c0, WIN, D, n0, scr, lane, false); continue; } r -= I_IN;
        if (r < I_G) { tr_item(C.w_in, NIN, 64 * r, 0, WIN, D, 5632, scr, lane, true); continue; } r -= I_G;
        if (r < I_PA) { tr_item(C.w_proj_a, D, 64 * (r / 32), 32 * (r % 32), WPA, AW, 32 * (r % 32), scr, lane, false); continue; } r -= I_PA;
        if (r < I_PB) { tr_item(C.w_proj_b, D, 64 * (r / 32), 32 * (r % 32), WPB, BW, 32 * (r % 32), scr, lane, false); continue; } r -= I_PB;
        if (r < I_OUT) { tr_item(C.w_out, D, 64 * (r / 32), 32 * (r % 32), WOUT, D, 32 * (r % 32), scr, lane, false); continue; } r -= I_OUT;
        if (r < I_UP) { tr_item(C.w_up, FF, 64 * (r / 128), 32 * (r % 128), WUP, D, 32 * (r % 128), scr, lane, false); continue; } r -= I_UP;
        if (r < I_DN) { tr_item(C.w_down, D, 64 * (r / 32), 32 * (r % 32), WDN, FF, 32 * (r % 32), scr, lane, false); continue; } r -= I_DN;
        tr_item(C.w_ada, NMODC, 64 * (r / 192), 32 * (r % 192), WADA, D, 32 * (r % 192), scr, lane, false);
    }
    for (int i = C.vcu * (NWAVES * 64) + C.tid; i < 28672; i += C.G * NWAVES * 64) ((GAS v4u*)(WIN + (size_t)5664 * D))[i] = (v4u){0u, 0u, 0u, 0u};
    for (int r = gw; r < 256; r += NGW) {
        const float* src = r < NB ? C.c_prompt + (size_t)r * D : (r < NB + DB ? C.c_sample + (size_t)(r - NB) * D : nullptr);
#pragma unroll
        for (int j = 0; j < 4; ++j) { f32x4 v = (f32x4){0.f, 0.f, 0.f, 0.f}; if (src) v = ((const f32x4*)src)[lane + 64 * j];
            u32x2 o; o.x = pk2(src ? siluf(v.x) : 0.f, src ? siluf(v.y) : 0.f); o.y = pk2(src ? siluf(v.z) : 0.f, src ? siluf(v.w) : 0.f);
            *(u32x2*)(SC + (size_t)r * D + 4 * (lane + 64 * j)) = o; }
    }
}

__device__ __forceinline__ void p2_norm1(const Ctx& C) {
    const int gw = C.vcu * NWAVES + C.wave, NGW = C.G * NWAVES, lane = C.lane;
    const float* MOD = (const float*)(C.ws + WS_MOD); bf16* XN = (bf16*)(C.ws + WS_XN);
    for (int m = gw; m < M; m += NGW) {
        const float* xr = m < MP ? C.x_prompt + (size_t)m * D : C.x_sample + (size_t)(m - MP) * D;
        const int mr = m < MP ? (m >> 12) : NB + ((m - MP) >> 2);
        const float* mod = MOD + (size_t)mr * NMODC;
        f32x4 v[4]; float s = 0.f;
#pragma unroll
        for (int j = 0; j < 4; ++j) { v[j] = ((const f32x4*)xr)[lane + 64 * j]; s += (v[j].x * v[j].x + v[j].y * v[j].y) + (v[j].z * v[j].z + v[j].w * v[j].w); }
        const float r = 1.0f / sqrtf(wave_sum(s) * (1.0f / D) + RMS_EPS);
#pragma unroll
        for (int j = 0; j < 4; ++j) { const int c = 4 * (lane + 64 * j);
            const f32x4 g = *(const f32x4*)(C.g_pre_mix + c), sc = *(const f32x4*)(mod + 1024 + c), sh = *(const f32x4*)(mod + c);
            const f32x4 h = (v[j] * r) * g * (sc + 1.0f) + sh;
            u32x2 o; o.x = pk2(h.x, h.y); o.y = pk2(h.z, h.w); *(u32x2*)(XN + (size_t)m * D + c) = o; }
    }
}

__device__ __forceinline__ void p9_norm2(const Ctx& C) {
    const int gw = C.vcu * NWAVES + C.wave, NGW = C.G * NWAVES, lane = C.lane;
    const float* MOD = (const float*)(C.ws + WS_MOD); bf16* XN = (bf16*)(C.ws + WS_XN); const float* Y = (const float*)(C.ws + WS_Y);
    for (int m = gw; m < M; m += NGW) {
        const float* xr = m < MP ? C.x_prompt + (size_t)m * D : C.x_sample + (size_t)(m - MP) * D;
        const int mr = m < MP ? (m >> 12) : NB + ((m - MP) >> 2);
        const float* mod = MOD + (size_t)mr * NMODC;
        f32x4 y[4]; float s = 0.f;
#pragma unroll
        for (int j = 0; j < 4; ++j) { y[j] = ((const f32x4*)(Y + (size_t)m * D))[lane + 64 * j]; s += (y[j].x * y[j].x + y[j].y * y[j].y) + (y[j].z * y[j].z + y[j].w * y[j].w); }
        const float r = 1.0f / sqrtf(wave_sum(s) * (1.0f / D) + RMS_EPS);
        float s2 = 0.f;
#pragma unroll
        for (int j = 0; j < 4; ++j) { const int c = 4 * (lane + 64 * j);
            const f32x4 g = *(const f32x4*)(C.g_post_mix + c), gt = *(const f32x4*)(mod + 2048 + c), x = ((const f32x4*)xr)[lane + 64 * j];
            y[j] = x + gt * ((y[j] * r) * g);
            *(f32x4*)(C.out + O_Y + (size_t)m * D + c) = y[j];
            s2 += (y[j].x * y[j].x + y[j].y * y[j].y) + (y[j].z * y[j].z + y[j].w * y[j].w); }
        const float r2 = 1.0f / sqrtf(wave_sum(s2) * (1.0f / D) + RMS_EPS);
#pragma unroll
        for (int j = 0; j < 4; ++j) { const int c = 4 * (lane + 64 * j);
            const f32x4 g = *(const f32x4*)(C.g_pre_mlp + c), sc = *(const f32x4*)(mod + 4096 + c), sh = *(const f32x4*)(mod + 3072 + c);
            const f32x4 h = (y[j] * r2) * g * (sc + 1.0f) + sh;
            u32x2 o; o.x = pk2(h.x, h.y); o.y = pk2(h.z, h.w); *(u32x2*)(XN + (size_t)m * D + c) = o; }
    }
}
__device__ __forceinline__ void p12_final(const Ctx& C) {
    const int gw = C.vcu * NWAVES + C.wave, NGW = C.G * NWAVES, lane = C.lane;
    const float* MOD = (const float*)(C.ws + WS_MOD); const float* Y = (const float*)(C.ws + WS_Y);
    for (int m = gw; m < M; m += NGW) {
        const int mr = m < MP ? (m >> 12) : NB + ((m - MP) >> 2);
        const float* mod = MOD + (size_t)mr * NMODC;
        f32x4 y[4]; float s = 0.f;
#pragma unroll
        for (int j = 0; j < 4; ++j) { y[j] = ((const f32x4*)(Y + (size_t)m * D))[lane + 64 * j]; s += (y[j].x * y[j].x + y[j].y * y[j].y) + (y[j].z * y[j].z + y[j].w * y[j].w); }
        const float r = 1.0f / sqrtf(wave_sum(s) * (1.0f / D) + RMS_EPS);
#pragma unroll
        for (int j = 0; j < 4; ++j) { const int c = 4 * (lane + 64 * j);
            const f32x4 g = *(const f32x4*)(C.g_post_mlp + c), gt = *(const f32x4*)(mod + 5120 + c);
            float* o = C.out + O_Y + (size_t)m * D + c; const f32x4 x1 = *(const f32x4*)o;
            *(f32x4*)o = x1 + gt * ((y[j] * r) * g); }
    }
}
__device__ __forceinline__ void p4_cumsum(const Ctx& C) {
    const int gw = C.vcu * NWAVES + C.wave, NGW = C.G * NWAVES, lane = C.lane;
    const float* LFA = (const float*)(C.ws + WS_LFA); float* GN = (float*)(C.ws + WS_GN);
    for (int bh = gw; bh < NB * AH; bh += NGW) {
        const int b = bh >> 3, h = bh & 7; const float* src = LFA + ((size_t)b * SEQ + 64 * lane) * AH + h;
        float tot = 0.f;
        for (int i = 0; i < 64; ++i) tot += src[(size_t)i * AH];
        const float incl = wave_scan_add(tot, lane); float run = incl - tot;
        float* dst = GN + (size_t)bh * SEQ + 64 * lane;
        for (int i = 0; i < 64; ++i) { run += src[(size_t)i * AH]; dst[i] = -LOG2E * run; }
    }
}

constexpr int KTP = 72;
constexpr int QTP = 136;
__device__ __forceinline__ void conv8(const Ctx& C, const bf16* QKB, size_t row, int tloc, int cc, const float* prev  , float (&y)[8]) {
    const f32x4 b0 = *(const f32x4*)(C.conv_b + cc), b1 = *(const f32x4*)(C.conv_b + cc + 4);
    y[0] = b0.x; y[1] = b0.y; y[2] = b0.z; y[3] = b0.w; y[4] = b1.x; y[5] = b1.y; y[6] = b1.z; y[7] = b1.w;
#pragma unroll
    for (int j = 0; j < 4; ++j) {
        const int tt = tloc - 3 + j; float x[8];
        if (tt >= 0) { const u16x8 xv = *(const u16x8*)(QKB + (row - 3 + j) * 1024 + cc);
#pragma unroll
            for (int e = 0; e < 8; ++e) x[e] = bf2f(xv[e]); }
        else if (prev) { const f32x4 p0 = *(const f32x4*)(prev + (size_t)(3 + tt) * 1024 + cc), p1 = *(const f32x4*)(prev + (size_t)(3 + tt) * 1024 + cc + 4);
            x[0] = p0.x; x[1] = p0.y; x[2] = p0.z; x[3] = p0.w; x[4] = p1.x; x[5] = p1.y; x[6] = p1.z; x[7] = p1.w; }
        else {
#pragma unroll
            for (int e = 0; e < 8; ++e) x[e] = 0.f; }
        const f32x4 w0 = *(const f32x4*)(C.conv_w + j * 1024 + cc), w1 = *(const f32x4*)(C.conv_w + j * 1024 + cc + 4);
        y[0] += w0.x * x[0]; y[1] += w0.y * x[1]; y[2] += w0.z * x[2]; y[3] += w0.w * x[3]; y[4] += w1.x * x[4]; y[5] += w1.y * x[5]; y[6] += w1.z * x[6]; y[7] += w1.w * x[7];
    }
#pragma unroll
    for (int e = 0; e < 8; ++e) y[e] = siluf(y[e]);
}

__device__ __forceinline__ void p4_mlstm_a(const Ctx& C) {
    const int tid = C.tid, lane = C.lane, wave = C.wave;
    const bf16* QKB = (const bf16*)(C.ws + WS_QKB); const bf16* VB = (const bf16*)(C.ws + WS_VB); bf16* MQ = (bf16*)(C.ws + WS_MQ); bf16* MK = (bf16*)(C.ws + WS_MK);
    const float* IPRE = (const float*)(C.ws + WS_IPRE); const float* LFB = (const float*)(C.ws + WS_LFB);
    float* KVT = (float*)(C.ws + WS_KVT); float* KN = (float*)(C.ws + WS_KN); float* BLML = (float*)(C.ws + WS_BLML);
    LAS bf16* KT = (LAS bf16*)(C.lds); LAS bf16* VT = (LAS bf16*)(C.lds + 18432); LAS float* sw = (LAS float*)(C.lds + 36864);
    for (int u = C.vcu; u < NB * BHN * 64; u += C.G) {
        const int bh = u >> 6, c = u & 63, b = bh >> 2, h = bh & 3; const size_t R0 = (size_t)b * SEQ + 64 * c;
        if (wave == 0) {
            const float ip = IPRE[(R0 + lane) * 4 + h], lf = LFB[(R0 + lane) * 4 + h];
            const float bc = wave_scan_add(lf, lane), bl = __shfl(bc, 63), wl = bl - bc + ip, ml = wave_max(wl);
            sw[lane] = __expf(wl - ml);
            if (lane == 0) { BLML[2 * u] = bl; BLML[2 * u + 1] = ml; }
        }
        __syncthreads();
#pragma unroll 1
        for (int i = 0; i < 4; ++i) { const int item = tid + 512 * i, tensor = item >> 10, t = (item >> 4) & 63, cg = item & 15, cc = tensor * 512 + h * 128 + cg * 8;
            float y[8]; conv8(C, QKB, R0 + t, 64 * c + t, cc, nullptr, y);
            if (tensor == 1) {
#pragma unroll
                for (int e = 0; e < 8; ++e) y[e] *= 0.08838834764831845f; }
            v4u o; o.x = pk2(y[0], y[1]); o.y = pk2(y[2], y[3]); o.z = pk2(y[4], y[5]); o.w = pk2(y[6], y[7]);
            *(v4u*)((tensor ? MK : MQ) + (R0 + t) * 512 + h * 128 + cg * 8) = o;
            if (tensor == 1) { const float w = sw[t];
#pragma unroll
                for (int e = 0; e < 8; ++e) KT[(cg * 8 + e) * KTP + t] = (bf16)f2bf(w * y[e]); }
        }
#pragma unroll
        for (int i = 0; i < 2; ++i) { const int item = tid + 512 * i, t = item >> 4, cg = item & 15;
            const u16x8 xv = *(const u16x8*)(VB + (R0 + t) * 512 + h * 128 + cg * 8);
#pragma unroll
            for (int e = 0; e < 8; ++e) VT[(cg * 8 + e) * KTP + t] = xv[e]; }
        __syncthreads();
        {
            const int fr = lane & 15, fq = lane >> 4;
            bf16x8 bfr[2];
#pragma unroll
            for (int ks = 0; ks < 2; ++ks) bfr[ks] = *(const LAS bf16x8*)(VT + (16 * wave + fr) * KTP + 32 * ks + 8 * fq);
            float* dst = KVT + (size_t)u * 16384 + (size_t)(16 * wave + fr) * 128 + 4 * fq;
#pragma unroll
            for (int dt = 0; dt < 8; ++dt) { f32x4 acc = (f32x4){0.f, 0.f, 0.f, 0.f};
#pragma unroll
                for (int ks = 0; ks < 2; ++ks) { const bf16x8 a = *(const LAS bf16x8*)(KT + (16 * dt + fr) * KTP + 32 * ks + 8 * fq); acc = MFMA16(a, bfr[ks], acc); }
                *(f32x4*)(dst + 16 * dt) = acc; }
        }
        if (tid < 128) { float s = 0.f;
#pragma unroll
            for (int k8 = 0; k8 < 8; ++k8) { const u16x8 xv = *(const LAS u16x8*)(KT + tid * KTP + 8 * k8);
#pragma unroll
                for (int e = 0; e < 8; ++e) s += bf2f(xv[e]); }
            KN[(size_t)u * 128 + tid] = s; }
        __syncthreads();
    }
}

__device__ __forceinline__ void p5_mlstm_b(const Ctx& C) {
    const float* KVT = (const float*)(C.ws + WS_KVT); const float* KN = (const float*)(C.ws + WS_KN); const float* BLML = (const float*)(C.ws + WS_BLML);
    bf16* CST = (bf16*)(C.ws + WS_CST); float* NST = (float*)(C.ws + WS_NST); float* MST = (float*)(C.ws + WS_MST);
    const int NT_ = C.G * NWAVES * 64;
    for (int idx = C.vcu * (NWAVES * 64) + C.tid; idx < 16 * 16384; idx += NT_) {
        const int bh = idx >> 14, rem = idx & 16383;
        float m = 0.f, cs = 0.f; const float* kv = KVT + (size_t)bh * 64 * 16384 + rem; bf16* cst = CST + (size_t)bh * 64 * 16384 + rem; const float* blml = BLML + bh * 128;
#pragma unroll 1
        for (int c0 = 0; c0 < 64; c0 += 8) { float kvv[8];
#pragma unroll
            for (int i = 0; i < 8; ++i) kvv[i] = kv[(size_t)(c0 + i) * 16384];
#pragma unroll
            for (int i = 0; i < 8; ++i) { const float bl = blml[2 * (c0 + i)], ml = blml[2 * (c0 + i) + 1];
                cst[(size_t)(c0 + i) * 16384] = (bf16)f2bf(cs);
                const float mn = fmaxf(bl + m, ml); cs = __expf(bl + m - mn) * cs + __expf(ml - mn) * kvv[i]; m = mn; } }
        C.out[O_CP + (size_t)bh * 16384 + (rem & 127) * 128 + (rem >> 7)] = cs;
    }
    for (int idx = C.vcu * (NWAVES * 64) + C.tid; idx < 16 * 128; idx += NT_) {
        const int bh = idx >> 7, d = idx & 127; float m = 0.f, ns = 0.f; const float* blml = BLML + bh * 128;
#pragma unroll 1
        for (int c = 0; c < 64; ++c) { const float bl = blml[2 * c], ml = blml[2 * c + 1], kn = KN[(size_t)(bh * 64 + c) * 128 + d];
            NST[(size_t)(bh * 64 + c) * 128 + d] = ns; if (d == 0) MST[bh * 64 + c] = m;
            const float mn = fmaxf(bl + m, ml); ns = __expf(bl + m - mn) * ns + __expf(ml - mn) * kn; m = mn; }
        C.out[O_NP + bh * 128 + d] = ns; if (d == 0) C.out[O_MP + bh] = m;
    }
}

__device__ __forceinline__ void p6_mlstm_c(const Ctx& C) {
    const int tid = C.tid, lane = C.lane, wave = C.wave, fr = lane & 15, fq = lane >> 4;
    const bf16* MQ = (const bf16*)(C.ws + WS_MQ); const bf16* MK = (const bf16*)(C.ws + WS_MK); const bf16* VB = (const bf16*)(C.ws + WS_VB); const bf16* SBO = (const bf16*)(C.ws + WS_SBO);
    const float* IPRE = (const float*)(C.ws + WS_IPRE); const float* LFB = (const float*)(C.ws + WS_LFB);
    const bf16* CST = (const bf16*)(C.ws + WS_CST); const float* NST = (const float*)(C.ws + WS_NST); const float* MST = (const float*)(C.ws + WS_MST); bf16* HB = (bf16*)(C.ws + WS_HB);
    LAS bf16* QT = (LAS bf16*)(C.lds); LAS bf16* KT2 = (LAS bf16*)(C.lds + 17408); LAS bf16* VT = (LAS bf16*)(C.lds + 34816); LAS bf16* AT = (LAS bf16*)(C.lds + 53248);
    LAS float* fb = (LAS float*)(C.lds + 62464); LAS float* bcs = fb; LAS float* us = fb + 64; LAS float* gts = fb + 128; LAS float* sis = fb + 192; LAS float* inv = fb + 256; LAS float* nsl = fb + 320;
    for (int u = C.vcu; u < NB * BHN * 64; u += C.G) {
        const int bh = u >> 6, c = u & 63, b = bh >> 2, h = bh & 3; const size_t R0 = (size_t)b * SEQ + 64 * c;
        const float mc = MST[u];
#pragma unroll
        for (int i = 0; i < 2; ++i) { const int item = tid + 512 * i, t = item >> 4, cg = item & 15; const size_t g = (R0 + t) * 512 + h * 128 + cg * 8;
            *(LAS v4u*)(QT + t * QTP + cg * 8) = *(const v4u*)(MQ + g); *(LAS v4u*)(KT2 + t * QTP + cg * 8) = *(const v4u*)(MK + g);
            const u16x8 xv = *(const u16x8*)(VB + g);
#pragma unroll
            for (int e = 0; e < 8; ++e) VT[(cg * 8 + e) * KTP + t] = xv[e]; }
        if (wave == 0) {
            const float ip = IPRE[(R0 + lane) * 4 + h], lf = LFB[(R0 + lane) * 4 + h];
            const float bc = wave_scan_add(lf, lane), uu = ip - bc, pm = wave_scan_max(uu, lane), g = fmaxf(mc, pm);
            bcs[lane] = bc; us[lane] = uu; gts[lane] = g; sis[lane] = __expf(mc - g);
        }
        if (wave == 1) { nsl[lane] = NST[(size_t)u * 128 + lane]; nsl[64 + lane] = NST[(size_t)u * 128 + 64 + lane]; }
        __syncthreads();
        {
            const int st = wave & 3;
#pragma unroll
            for (int q = 0; q < 2; ++q) { const int tt = 2 * (wave >> 2) + q; f32x4 acc = (f32x4){0.f, 0.f, 0.f, 0.f};
                if (st <= tt) {
#pragma unroll
                    for (int ks = 0; ks < 4; ++ks) { const bf16x8 a = *(const LAS bf16x8*)(KT2 + (16 * st + fr) * QTP + 32 * ks + 8 * fq), bb = *(const LAS bf16x8*)(QT + (16 * tt + fr) * QTP + 32 * ks + 8 * fq);
                        acc = MFMA16(a, bb, acc); } }
                const int t = 16 * tt + fr, s0 = 16 * st + 4 * fq; const float g = gts[t]; float av[4];
#pragma unroll
                for (int e = 0; e < 4; ++e) av[e] = (s0 + e <= t) ? __expf(us[s0 + e] - g) * acc[e] : 0.f;
                u32x2 o; o.x = pk2(av[0], av[1]); o.y = pk2(av[2], av[3]); *(LAS u32x2*)(AT + t * KTP + s0) = o; }
        }
        __syncthreads();
        if (tid < 64) {
            const int t = tid; float rs = 0.f, qn = 0.f;
#pragma unroll
            for (int k8 = 0; k8 < 8; ++k8) { const u16x8 xv = *(const LAS u16x8*)(AT + t * KTP + 8 * k8);
#pragma unroll
                for (int e = 0; e < 8; ++e) rs += bf2f(xv[e]); }
#pragma unroll
            for (int k8 = 0; k8 < 16; ++k8) { const u16x8 xv = *(const LAS u16x8*)(QT + t * QTP + 8 * k8);
#pragma unroll
                for (int e = 0; e < 8; ++e) qn += bf2f(xv[e]) * nsl[8 * k8 + e]; }
            const float den = rs + sis[t] * qn, mt = bcs[t] + gts[t];
            inv[t] = 1.0f / fmaxf(fabsf(den), __expf(-mt));
        }
        {
            bf16x8 av[2], ac[4];
#pragma unroll
            for (int ks = 0; ks < 2; ++ks) av[ks] = *(const LAS bf16x8*)(VT + (16 * wave + fr) * KTP + 32 * ks + 8 * fq);
#pragma unroll
            for (int ks = 0; ks < 4; ++ks) ac[ks] = *(const bf16x8*)(CST + (size_t)u * 16384 + (size_t)(16 * wave + fr) * 128 + 32 * ks + 8 * fq);
            f32x4 a1[4], a2[4];
#pragma unroll
            for (int tt = 0; tt < 4; ++tt) { a1[tt] = (f32x4){0.f, 0.f, 0.f, 0.f}; a2[tt] = (f32x4){0.f, 0.f, 0.f, 0.f};
#pragma unroll
                for (int ks = 0; ks < 2; ++ks) { const bf16x8 bb = *(const LAS bf16x8*)(AT + (16 * tt + fr) * KTP + 32 * ks + 8 * fq); a1[tt] = MFMA16(av[ks], bb, a1[tt]); }
#pragma unroll
                for (int ks = 0; ks < 4; ++ks) { const bf16x8 bb = *(const LAS bf16x8*)(QT + (16 * tt + fr) * QTP + 32 * ks + 8 * fq); a2[tt] = MFMA16(ac[ks], bb, a2[tt]); } }
            __syncthreads();
#pragma unroll
            for (int tt = 0; tt < 4; ++tt) { const int t = 16 * tt + fr; const float si = sis[t], iv = inv[t]; const size_t g = (R0 + t) * 512 + h * 128 + 16 * wave + 4 * fq;
                const u16x4 sb = *(const u16x4*)(SBO + g); float hv[4];
#pragma unroll
                for (int e = 0; e < 4; ++e) hv[e] = (a1[tt][e] + si * a2[tt][e]) * iv * bf2f(sb[e]);
                u32x2 o; o.x = pk2(hv[0], hv[1]); o.y = pk2(hv[2], hv[3]); *(u32x2*)(HB + g) = o; }
        }
        __syncthreads();
    }
}
__device__ __forceinline__ void p4_mlstm_sample(const Ctx& C) {
    const int tid = C.tid;
    const bf16* QKB = (const bf16*)(C.ws + WS_QKB); const bf16* VB = (const bf16*)(C.ws + WS_VB); const bf16* SBO = (const bf16*)(C.ws + WS_SBO); bf16* HB = (bf16*)(C.ws + WS_HB);
    const float* IPRE = (const float*)(C.ws + WS_IPRE); const float* LFB = (const float*)(C.ws + WS_LFB);
    LAS float* sq = (LAS float*)(C.lds + 65536); LAS float* sk = sq + 512; LAS float* sv = sk + 512; LAS float* wk = sv + 512; LAS float* red = wk + 512;
    LAS float* sm = red + 2048;
    for (int u = C.vcu; u < DB * BHN; u += C.G) {
        const int b = u >> 2, h = u & 3; const size_t R0 = (size_t)MP + 4 * b; const size_t sbase = (size_t)u * 128;
        if (tid < 128) { const int tensor = tid >> 6, t = (tid >> 4) & 3, cg = tid & 15, cc = tensor * 512 + h * 128 + cg * 8; float y[8];
            conv8(C, QKB, R0 + t, t, cc, C.state_conv + (size_t)b * 3 * 1024, y);
#pragma unroll
            for (int e = 0; e < 8; ++e) (tensor ? sk : sq)[t * 128 + cg * 8 + e] = tensor ? y[e] * 0.08838834764831845f : y[e]; }
        { const int t = tid >> 7, e = tid & 127; sv[t * 128 + e] = bf2f(VB[(R0 + t) * 512 + h * 128 + e]); }
        if (tid == 0) { const float m0 = C.state_m[u]; float bc = 0.f, pm = -INFINITY, uu[4], g[4];
#pragma unroll
            for (int t = 0; t < 4; ++t) { bc += LFB[(R0 + t) * 4 + h]; uu[t] = IPRE[(R0 + t) * 4 + h] - bc; pm = fmaxf(pm, uu[t]); g[t] = fmaxf(m0, pm);
                sm[t] = uu[t]; sm[4 + t] = g[t]; sm[8 + t] = __expf(m0 - g[t]); sm[12 + t] = bc + g[t]; }
#pragma unroll
            for (int s = 0; s < 4; ++s) sm[36 + s] = __expf(uu[s] - g[3]); }
        __syncthreads();
        if (tid < 16) { const int t = tid >> 2, s = tid & 3; float d = 0.f;
            for (int k = 0; k < 128; ++k) d += sq[t * 128 + k] * sk[s * 128 + k];
            sm[16 + tid] = (s <= t) ? __expf(sm[s] - sm[4 + t]) * d : 0.f; }
        else if (tid >= 64 && tid < 68) { const int t = tid - 64; float d = 0.f;
            for (int k = 0; k < 128; ++k) d += sq[t * 128 + k] * C.state_n[sbase + k];
            sm[32 + t] = d; }
        { const int s = tid >> 7, d = tid & 127; wk[s * 128 + d] = sm[36 + s] * sk[s * 128 + d]; }
        __syncthreads();
        {
            const int e = tid & 127, dq = tid >> 7; const float decay = sm[8 + 3]; float p0 = 0.f, p1 = 0.f, p2 = 0.f, p3 = 0.f;
            const float v0 = sv[e], v1 = sv[128 + e], v2 = sv[256 + e], v3 = sv[384 + e];
            const float* c0p = C.state_C + (sbase + 32 * dq) * 128 + e; float* cnp = C.out + O_CS + (sbase + 32 * dq) * 128 + e;
#pragma unroll 8
            for (int dd = 0; dd < 32; ++dd) { const int d = 32 * dq + dd; const float c0 = c0p[(size_t)dd * 128];
                p0 += sq[d] * c0; p1 += sq[128 + d] * c0; p2 += sq[256 + d] * c0; p3 += sq[384 + d] * c0;
                cnp[(size_t)dd * 128] = decay * c0 + (wk[d] * v0 + wk[128 + d] * v1) + (wk[256 + d] * v2 + wk[384 + d] * v3); }
            red[(dq * 4 + 0) * 128 + e] = p0; red[(dq * 4 + 1) * 128 + e] = p1; red[(dq * 4 + 2) * 128 + e] = p2; red[(dq * 4 + 3) * 128 + e] = p3;
        }
        __syncthreads();
        { const int t = tid >> 7, e = tid & 127; float num = 0.f, den = 0.f;
#pragma unroll
            for (int s = 0; s < 4; ++s) { const float a = sm[16 + t * 4 + s]; num += a * sv[s * 128 + e]; den += a; }
            const float si = sm[8 + t]; num += si * ((red[(0 * 4 + t) * 128 + e] + red[(1 * 4 + t) * 128 + e]) + (red[(2 * 4 + t) * 128 + e] + red[(3 * 4 + t) * 128 + e]));
            den += si * sm[32 + t];
            const float hv = num / fmaxf(fabsf(den), __expf(-sm[12 + t]));
            const size_t g = (R0 + t) * 512 + h * 128 + e; HB[g] = (bf16)f2bf(hv * bf2f(SBO[g])); }
        if (tid < 128) { const int d = tid; C.out[O_NS + sbase + d] = sm[8 + 3] * C.state_n[sbase + d] + (wk[d] + wk[128 + d]) + (wk[256 + d] + wk[384 + d]); }
        if (tid == 0) C.out[O_MS + u] = sm[12 + 3];
        __syncthreads();
    }
}

__device__ __forceinline__ float red16(float v) {
    v += __shfl_xor(v, 1); v += __shfl_xor(v, 2); v += __shfl_xor(v, 4); v += __shfl_xor(v, 8); return v;
}
__device__ __forceinline__ void p4_decode1(const Ctx& C) {
    const int lane = C.lane, h = C.wave, l15 = lane & 15, grp = lane >> 4;
    const bf16* QA = (const bf16*)(C.ws + WS_QA); float* PART = (float*)(C.ws + WS_PART);
    LAS float* gl = (LAS float*)(C.lds + 98304) + h * 640; LAS float* sc = gl + 128;
    for (int it = C.vcu; it < DB * NPAGES; it += C.G) {
        const int b = it >> 4, p = it & 15; const int phys = C.page_table[b * NPAGES + p];
        const float* kb = C.cache_k + ((size_t)phys * PAGE * AH + h) * 64 + 4 * l15; const float* vb = C.cache_v + ((size_t)phys * PAGE * AH + h) * 64 + 4 * l15;
        const float lf0 = C.cache_logf[((size_t)phys * PAGE + lane) * AH + h] * LOG2E, lf1 = C.cache_logf[((size_t)phys * PAGE + 64 + lane) * AH + h] * LOG2E;
        const float s0 = wave_scan_add(lf0, lane), t0 = __shfl(s0, 63), s1 = wave_scan_add(lf1, lane) + t0, T = __shfl(s1, 63);
        gl[lane] = s0; gl[64 + lane] = s1;
        f32x4 q[4];
#pragma unroll
        for (int j = 0; j < 4; ++j) { const u16x4 qv = *(const u16x4*)(QA + ((size_t)MP + 4 * b + j) * 512 + h * 64 + 4 * l15); q[j] = (f32x4){bf2f(qv[0]), bf2f(qv[1]), bf2f(qv[2]), bf2f(qv[3])}; }
#pragma unroll 1
        for (int i0 = 0; i0 < 32; i0 += 8) { f32x4 kv[8];
#pragma unroll
            for (int i = 0; i < 8; ++i) kv[i] = *(const f32x4*)(kb + (size_t)(4 * (i0 + i) + grp) * (AH * 64));
#pragma unroll
            for (int i = 0; i < 8; ++i) { const int tk = 4 * (i0 + i) + grp; float d[4];
#pragma unroll
                for (int j = 0; j < 4; ++j) d[j] = red16((kv[i].x * q[j].x + kv[i].y * q[j].y) + (kv[i].z * q[j].z + kv[i].w * q[j].w));
                if (l15 == 0) { const float g = gl[tk]; *(LAS f32x4*)(sc + 4 * tk) = (f32x4){d[0] - g, d[1] - g, d[2] - g, d[3] - g}; } } }
        f32x4 sa = *(const LAS f32x4*)(sc + 4 * lane), sb = *(const LAS f32x4*)(sc + 4 * (64 + lane)); float mj[4], lj[4];
#pragma unroll
        for (int j = 0; j < 4; ++j) { mj[j] = wave_max(fmaxf(sa[j], sb[j])); sa[j] = __builtin_amdgcn_exp2f(sa[j] - mj[j]); sb[j] = __builtin_amdgcn_exp2f(sb[j] - mj[j]); lj[j] = wave_sum(sa[j] + sb[j]); }
        *(LAS f32x4*)(sc + 4 * lane) = sa; *(LAS f32x4*)(sc + 4 * (64 + lane)) = sb;
        f32x4 acc[4];
#pragma unroll
        for (int j = 0; j < 4; ++j) acc[j] = (f32x4){0.f, 0.f, 0.f, 0.f};
#pragma unroll 1
        for (int i0 = 0; i0 < 32; i0 += 8) { f32x4 vv[8];
#pragma unroll
            for (int i = 0; i < 8; ++i) vv[i] = *(const f32x4*)(vb + (size_t)(4 * (i0 + i) + grp) * (AH * 64));
#pragma unroll
            for (int i = 0; i < 8; ++i) { const f32x4 pj = *(const LAS f32x4*)(sc + 4 * (4 * (i0 + i) + grp));
#pragma unroll
                for (int j = 0; j < 4; ++j) acc[j] += vv[i] * pj[j]; } }
#pragma unroll
        for (int j = 0; j < 4; ++j)
#pragma unroll
            for (int e = 0; e < 4; ++e) { float a = acc[j][e]; a += __shfl_xor(a, 16); a += __shfl_xor(a, 32); acc[j][e] = a; }
        float* dst = PART + ((size_t)(it * AH + h) * 4) * PART_STRIDE;
        if (grp == 0) {
#pragma unroll
            for (int j = 0; j < 4; ++j) *(f32x4*)(dst + j * PART_STRIDE + 4 * l15) = acc[j]; }
        if (lane == 0) {
#pragma unroll
            for (int j = 0; j < 4; ++j) { dst[j * PART_STRIDE + 64] = mj[j]; dst[j * PART_STRIDE + 65] = lj[j]; dst[j * PART_STRIDE + 66] = T; } }
    }
}

__device__ __forceinline__ void p6_decode2(const Ctx& C) {
    const int tid = C.tid, h = tid >> 6, j = (tid >> 4) & 3, ch = tid & 15;
    const bf16* QA = (const bf16*)(C.ws + WS_QA); const bf16* KA = (const bf16*)(C.ws + WS_KA); const bf16* VA = (const bf16*)(C.ws + WS_VA); bf16* OA = (bf16*)(C.ws + WS_OA);
    const float* LFA = (const float*)(C.ws + WS_LFA); const float* PART = (const float*)(C.ws + WS_PART);
    for (int b = C.vcu; b < DB; b += C.G) {
        const size_t R0 = (size_t)MP + 4 * b;
        float mt[NPAGES], lp[NPAGES]; float pre = 0.f, Mx = -INFINITY;
#pragma unroll
        for (int p = 0; p < NPAGES; ++p) { const float* src = PART + ((size_t)((b * NPAGES + p) * AH + h) * 4 + j) * PART_STRIDE;
            mt[p] = src[64] - pre; lp[p] = src[65]; pre += src[66]; Mx = fmaxf(Mx, mt[p]); }
        const u16x4 qv = *(const u16x4*)(QA + (R0 + j) * 512 + h * 64 + 4 * ch); float sn[4]; float g2 = pre;
#pragma unroll
        for (int i = 0; i < 4; ++i) { const u16x4 kv = *(const u16x4*)(KA + (R0 + i) * 512 + h * 64 + 4 * ch);
            const float d = red16((bf2f(qv[0]) * bf2f(kv[0]) + bf2f(qv[1]) * bf2f(kv[1])) + (bf2f(qv[2]) * bf2f(kv[2]) + bf2f(qv[3]) * bf2f(kv[3])));
            g2 += LFA[(R0 + i) * AH + h] * LOG2E; sn[i] = (i <= j) ? d - g2 : -INFINITY; Mx = fmaxf(Mx, sn[i]); }
        float L = 0.f; f32x4 acc = (f32x4){0.f, 0.f, 0.f, 0.f};
#pragma unroll
        for (int p = 0; p < NPAGES; ++p) { const float* src = PART + ((size_t)((b * NPAGES + p) * AH + h) * 4 + j) * PART_STRIDE; const float w = __builtin_amdgcn_exp2f(mt[p] - Mx);
            L += lp[p] * w; acc += *(const f32x4*)(src + 4 * ch) * w; }
#pragma unroll
        for (int i = 0; i < 4; ++i) { const float w = __builtin_amdgcn_exp2f(sn[i] - Mx); const u16x4 vv = *(const u16x4*)(VA + (R0 + i) * 512 + h * 64 + 4 * ch);
            L += w; acc += (f32x4){bf2f(vv[0]), bf2f(vv[1]), bf2f(vv[2]), bf2f(vv[3])} * w; }
        const float il = 1.0f / L; u32x2 o; o.x = pk2(acc.x * il, acc.y * il); o.y = pk2(acc.z * il, acc.w * il);
        *(u32x2*)(OA + (R0 + j) * 512 + h * 64 + 4 * ch) = o;
    }
}
struct Args { const void* in[29]; float* out; unsigned char* ws; int ph_lo, ph_hi; };
static_assert(sizeof(Args) == 256, "Args has no padding bytes");
__global__ void __launch_bounds__(NWAVES * 64, 2) fox_fwd(Args args) {
    extern __shared__ __attribute__((aligned(16))) unsigned char lds[];
    Ctx C;
    C.lds = (LAS unsigned char*)lds;
    volatile LAS unsigned* MISC = (volatile LAS unsigned*)(C.lds + MISC_OFF);
    C.tid = threadIdx.x; C.lane = C.tid & 63; C.wave = __builtin_amdgcn_readfirstlane(C.tid >> 6);
    C.G = gridDim.x; { const int bx = blockIdx.x; C.vcu = (C.G % 8 == 0) ? (bx % 8) * (C.G / 8) + bx / 8 : bx; }
    C.ws = args.ws; C.out = args.out; C.ctl = (gu32*)(args.ws + WS_CTL);
    C.x_prompt = (const float*)args.in[0]; C.x_sample = (const float*)args.in[1]; C.cache_k = (const float*)args.in[2]; C.cache_v = (const float*)args.in[3]; C.cache_logf = (const float*)args.in[4];
    C.page_table = (const int*)args.in[5]; C.state_C = (const float*)args.in[6]; C.state_n = (const float*)args.in[7]; C.state_m = (const float*)args.in[8]; C.state_conv = (const float*)args.in[9];
    C.c_prompt = (const float*)args.in[10]; C.c_sample = (const float*)args.in[11]; C.w_ada = (const float*)args.in[12]; C.b_ada = (const float*)args.in[13];
    C.g_pre_mix = (const float*)args.in[14]; C.g_post_mix = (const float*)args.in[15]; C.g_pre_mlp = (const float*)args.in[16]; C.g_post_mlp = (const float*)args.in[17];
    C.w_in = (const float*)args.in[18]; C.b_fox_f = (const float*)args.in[19]; C.b_ml_i = (const float*)args.in[20]; C.b_ml_f = (const float*)args.in[21];
    C.conv_w = (const float*)args.in[22]; C.conv_b = (const float*)args.in[23]; C.w_proj_a = (const float*)args.in[24]; C.w_proj_b = (const float*)args.in[25];
    C.w_out = (const float*)args.in[26]; C.w_up = (const float*)args.in[27]; C.w_down = (const float*)args.in[28];
    unsigned char* ws = args.ws;
    for (int u = C.tid; u < (LDS_BYTES - LDSCTL_OFF) / 4; u += NWAVES * 64) ((LAS unsigned*)(C.lds + LDSCTL_OFF))[u] = 0u;
    __syncthreads();
    XcdBarrier bar; bar.bar = (unsigned*)(C.ctl + CW_BAR); bar.x = 0; bar.st = nullptr;
    if (ONE_LAUNCH) bar = xcd_barrier_post((unsigned*)(C.ctl + CW_BAR), MISC + 8);
#define GRID_BAR() do { if (ONE_LAUNCH) xcd_barrier(bar); } while (0)
    const int lo = args.ph_lo, hi = args.ph_hi;
#define IN(k) (lo <= (k) && (k) < hi)
#define BOTH(k) (IN(k) && IN((k) + 1))
    typedef pg8::StaticOrder SO;
    if (IN(0)) { p0_prologue(C); if (BOTH(0)) GRID_BAR(); }
    if (IN(1)) { pg8::Gemm g{(const bf16*)(ws + WS_SC), (const bf16*)(ws + WS_WADA), 256, NMODC, D}; SO S; S.init(256, NMODC, C.G, (int)blockIdx.x);
        pg8::EpiF32 E{(float*)(ws + WS_MOD), NMODC, C.b_ada};
        pg8::gemm_phase<pg8::EpiF32, SO, true, true>(C.lds + RING_OFF, g, S, E);
        if (BOTH(1)) GRID_BAR(); }
    if (IN(2)) { p2_norm1(C); if (BOTH(2)) GRID_BAR(); }
    if (IN(3)) { pg8::Gemm g{(const bf16*)(ws + WS_XN), (const bf16*)(ws + WS_WIN), M, NINP, D}; SO S; S.init(M, NINP, C.G, (int)blockIdx.x);
        pg8::EpiIn E{(bf16*)(ws + WS_QA), (bf16*)(ws + WS_KA), (bf16*)(ws + WS_VA), (bf16*)(ws + WS_QKB), (bf16*)(ws + WS_VB), (bf16*)(ws + WS_SBO), (bf16*)(ws + WS_SGA), (bf16*)(ws + WS_SGB),
            (float*)(ws + WS_LFA), (float*)(ws + WS_IPRE), (float*)(ws + WS_LFB), C.out, C.b_fox_f, C.b_ml_i, C.b_ml_f, MP, O_KP, O_VP, O_LFP, O_CVP, O_KS, O_VS, O_LFS, O_CVS, attn_body::C2};
        pg8::gemm_phase<pg8::EpiIn, SO, true, true>(C.lds + RING_OFF, g, S, E);
        if (BOTH(3)) GRID_BAR(); }
    if (IN(4)) { p4_cumsum(C); p4_mlstm_a(C); p4_mlstm_sample(C); p4_decode1(C); if (BOTH(4)) GRID_BAR(); }
    if (IN(5)) { p5_mlstm_b(C); if (BOTH(5)) GRID_BAR(); }
    if (IN(6)) {
        static_assert(attn_body::ATTN_LDS_BYTES <= RING_BYTES, "attention LDS");
        const attn_body::AttnTensors AT{(const attn_body::bf16*)(ws + WS_QA), (const attn_body::bf16*)(ws + WS_KA), (const attn_body::bf16*)(ws + WS_VA), (attn_body::bf16*)(ws + WS_OA), (const float*)(ws + WS_GN)};
        const attn_body::StaticOrder S((int)C.G, C.vcu);
        attn_body::attn_phase<attn_body::StaticOrder>((char*)lds + RING_OFF, AT, S);
        __syncthreads();
        p6_mlstm_c(C); p6_decode2(C);
        if (BOTH(6)) GRID_BAR(); }
    if (IN(7)) {
        { pg8::Gemm g{(const bf16*)(ws + WS_OA), (const bf16*)(ws + WS_WPA), M, D, AW}; SO S; S.init(M, D, C.G, (int)blockIdx.x);
          pg8::EpiGateA E{(float*)(ws + WS_T1), (const bf16*)(ws + WS_SGA), D};
          pg8::gemm_phase<pg8::EpiGateA, SO, true, true>(C.lds + RING_OFF, g, S, E); }
        VM_WAIT(); __syncthreads();
        { pg8::Gemm g{(const bf16*)(ws + WS_HB), (const bf16*)(ws + WS_WPB), M, D, BW}; SO S; S.init(M, D, C.G, (int)blockIdx.x);
          pg8::EpiGateB E{(const float*)(ws + WS_T1), (const bf16*)(ws + WS_SGB), (bf16*)(ws + WS_T), D};
          pg8::gemm_phase<pg8::EpiGateB, SO, true, true>(C.lds + RING_OFF, g, S, E); }
        if (BOTH(7)) GRID_BAR(); }
    if (IN(8)) { pg8::Gemm g{(const bf16*)(ws + WS_T), (const bf16*)(ws + WS_WOUT), M, D, D}; SO S; S.init(M, D, C.G, (int)blockIdx.x);
        pg8::EpiF32 E{(float*)(ws + WS_Y), D, nullptr};
        pg8::gemm_phase<pg8::EpiF32, SO, true, true>(C.lds + RING_OFF, g, S, E);
        if (BOTH(8)) GRID_BAR(); }
    if (IN(9)) { p9_norm2(C); if (BOTH(9)) GRID_BAR(); }
    if (IN(10)) { pg8::Gemm g{(const bf16*)(ws + WS_XN), (const bf16*)(ws + WS_WUP), M, FF, D}; SO S; S.init(M, FF, C.G, (int)blockIdx.x);
        pg8::EpiRelu2 E{(bf16*)(ws + WS_U), FF};
        pg8::gemm_phase<pg8::EpiRelu2, SO, true, true>(C.lds + RING_OFF, g, S, E);
        if (BOTH(10)) GRID_BAR(); }
    if (IN(11)) { pg8::Gemm g{(const bf16*)(ws + WS_U), (const bf16*)(ws + WS_WDN), M, D, FF}; SO S; S.init(M, D, C.G, (int)blockIdx.x);
        pg8::EpiF32 E{(float*)(ws + WS_Y), D, nullptr};
        pg8::gemm_phase<pg8::EpiF32, SO, true, true>(C.lds + RING_OFF, g, S, E);
        if (BOTH(11)) GRID_BAR(); }
    if (IN(12)) { p12_final(C); }
#undef IN
#undef BOTH
}

extern "C" void kernel_launch(void* const* d_in, const int* in_sizes, int n_in, void* d_out, int out_size, void* d_ws, size_t ws_size, hipStream_t stream) {
    static int grid = 0;
    if (grid == 0) {
        if (n_in != 29 || out_size != O_END || ws_size < WS_END) { fprintf(stderr, "kernel_launch: unexpected shapes: n_in %d out %d ws %zu; nothing launched\n", n_in, out_size, ws_size); grid = -1; return; }
        int dev = 0, cus = 0, per_cu = 0;
        if (hipGetDevice(&dev) != hipSuccess || hipDeviceGetAttribute(&cus, hipDeviceAttributeMultiprocessorCount, dev) != hipSuccess) { fprintf(stderr, "kernel_launch: device query failed\n"); grid = -1; return; }
        if (hipFuncSetAttribute((const void*)fox_fwd, hipFuncAttributeMaxDynamicSharedMemorySize, LDS_BYTES) != hipSuccess) { fprintf(stderr, "kernel_launch: hipFuncSetAttribute failed\n"); grid = -1; return; }
        if (hipOccupancyMaxActiveBlocksPerMultiprocessor(&per_cu, (const void*)fox_fwd, NWAVES * 64, LDS_BYTES) != hipSuccess || per_cu < 1)
            fprintf(stderr, "kernel_launch: note: occupancy query reports %d workgroups per CU\n", per_cu);
        (void)hipGetLastError();
        grid = cus;
    }
    if (grid < 0) return;
    if (hipMemsetAsync((char*)d_ws + WS_CTL, 0, CTL_ZERO_BYTES, stream) != hipSuccess) { fprintf(stderr, "kernel_launch: memset failed\n"); return; }
    Args a{};
    for (int i = 0; i < 29; ++i) a.in[i] = d_in[i];
    a.out = (float*)d_out; a.ws = (unsigned char*)d_ws;
    if (ONE_LAUNCH) { a.ph_lo = 0; a.ph_hi = NPH; hipLaunchKernelGGL(fox_fwd, dim3(grid), dim3(NWAVES * 64), LDS_BYTES, stream, a); }
    else for (int p = 0; p < NPH; ++p) { a.ph_lo = p; a.ph_hi = p + 1; hipLaunchKernelGGL(fox_fwd, dim3(grid), dim3(NWAVES * 64), LDS_BYTES, stream, a); }
    const hipError_t le = hipPeekAtLastError();
    if (le != hipSuccess) fprintf(stderr, "kernel_launch: launch failed: %s\n", hipGetErrorName(le));
}
```

```cpp
#define MK_N_LAUNCHES 1
#include <hip/hip_runtime.h>
#include <cstdio>
#include <cstdint>
namespace pg8 {
#define PG8_LAS __attribute__((address_space(3)))
typedef unsigned short bf16_t;
typedef short bf16x8 __attribute__((ext_vector_type(8)));
typedef float f32x4 __attribute__((ext_vector_type(4)));
typedef unsigned u32x4 __attribute__((ext_vector_type(4)));
constexpr int BM = 256, BK = 64, HALF = 128, HTB = HALF * BK * 2  , STAGE_BYTES = 8 * HTB, NXCD = 8, WGM = 8;

__host__ __device__ __forceinline__ int lds_byte(int r, int c) { const int st = (r >> 4) * 2 + (c >> 5), rr = r & 15, cc = c & 31, ob = rr * 64 + cc * 2; return st * 1024 + (ob ^ (((ob >> 9) & 1) << 5)); }
__host__ __device__ __forceinline__ void stage_rc(int b, int& R, int& C) { const int st = b / 1024, sb = b % 1024, swz = sb ^ (((sb >> 9) & 1) << 5); R = (st >> 1) * 16 + swz / 64; C = (st & 1) * 32 + (swz % 64) / 2; }
__host__ __device__ __forceinline__ int perm32(int rho) { const int n = rho >> 4, i = rho & 15; return 8 * (i >> 2) + 4 * n + (i & 3); }

struct Unit { int pm, pn; };
struct Gemm { const bf16_t* A; const bf16_t* Bt; int M, N, K; };

struct StaticOrder {
    int nM, nN, nwg, G, c;
    __host__ __device__ void init(int M, int N, int G_, int c_) { nM = M / BM; nN = N / BM; nwg = nM * nN; G = G_; c = c_; }
    __host__ __device__ bool next(int i, Unit& u) const {
        const long L = (long)i * G + c; if (L >= nwg) return false;
        int wgid = (int)L; { const int q = nwg / NXCD, r = nwg % NXCD, xcd = wgid % NXCD, off = wgid / NXCD; wgid = (xcd < r ? xcd * (q + 1) : r * (q + 1) + (xcd - r) * q) + off; }
        const int nig = WGM * nN, gid = wgid / nig, fm = gid * WGM, gsz = (nM - fm) < WGM ? (nM - fm) : WGM;
        u.pm = fm + ((wgid % nig) % gsz); u.pn = (wgid % nig) / gsz; return true;
    }
    __device__ __forceinline__ void a_ready(const Unit&) const {}
    __device__ __forceinline__ void done(const Unit&) const {}
};

__device__ __forceinline__ unsigned cvt_pk_bf16(float lo, float hi) { unsigned r; asm volatile("v_cvt_pk_bf16_f32 %0, %1, %2" : "=v"(r) : "v"(lo), "v"(hi)); return r; }
typedef float f32x2 __attribute__((ext_vector_type(2)));
typedef unsigned short u16x8v __attribute__((ext_vector_type(8)));
__device__ __forceinline__ float bf2f(unsigned short b) { return __uint_as_float(((unsigned)b) << 16); }
__device__ __forceinline__ float sigm(float x) { return 1.0f / (1.0f + __expf(-x)); }
__device__ __forceinline__ float logsig(float x) { return fminf(x, 0.f) - log1pf(__expf(-fabsf(x))); }
__device__ __forceinline__ u32x4 pack8(const f32x4 v0, const f32x4 v1) { u32x4 w; w.x = cvt_pk_bf16(v0[0], v0[1]); w.y = cvt_pk_bf16(v0[2], v0[3]); w.z = cvt_pk_bf16(v1[0], v1[1]); w.w = cvt_pk_bf16(v1[2], v1[3]); return w; }

#define PG8_EPI_WALK(...) \
    _Pragma("unroll") for (int ai = 0; ai < 2; ++ai) _Pragma("unroll") for (int m = 0; m < 4; ++m) { const int row = u.pm * BM + ai * HALF + wr * 64 + m * 16 + fr; \
        _Pragma("unroll") for (int bj = 0; bj < 2; ++bj) { const int cl = bj * HALF + wc * 32 + 8 * fq; f32x4 v0 = acc[ai][bj][m][0], v1 = acc[ai][bj][m][1]; __VA_ARGS__ } }

struct EpiF32 {
    static constexpr bool PERM = true, AFTER_DRAIN = false;
    float* O; int ldc; const float* bias;
    __device__ __forceinline__ void operator()(const f32x4 (&acc)[2][2][4][2], const Unit& u, int wr, int wc, int fr, int fq) const {
        PG8_EPI_WALK({ const int col = u.pn * BM + cl; if (bias) { v0 += *(const f32x4*)(bias + col); v1 += *(const f32x4*)(bias + col + 4); }
            float* p = O + (size_t)row * ldc + col; *(f32x4*)p = v0; *(f32x4*)(p + 4) = v1; })
    }
};
struct EpiRelu2 {
    static constexpr bool PERM = true, AFTER_DRAIN = false;
    bf16_t* O; int ldc;
    __device__ __forceinline__ void operator()(const f32x4 (&acc)[2][2][4][2], const Unit& u, int wr, int wc, int fr, int fq) const {
        PG8_EPI_WALK({ const int col = u.pn * BM + cl;
            _Pragma("unroll") for (int e = 0; e < 4; ++e) { const float a = fmaxf(v0[e], 0.f), b = fmaxf(v1[e], 0.f); v0[e] = a * a; v1[e] = b * b; }
            *(u32x4*)(O + (size_t)row * ldc + col) = pack8(v0, v1); })
    }
};
struct EpiGateA {
    static constexpr bool PERM = true, AFTER_DRAIN = false;
    float* T1; const bf16_t* SG; int ldc;
    __device__ __forceinline__ void operator()(const f32x4 (&acc)[2][2][4][2], const Unit& u, int wr, int wc, int fr, int fq) const {
        PG8_EPI_WALK({ const int col = u.pn * BM + cl; const size_t off = (size_t)row * ldc + col;
            const u16x8v g = *(const u16x8v*)(SG + off);
            _Pragma("unroll") for (int e = 0; e < 4; ++e) { v0[e] *= bf2f(g[e]); v1[e] *= bf2f(g[4 + e]); }
            *(f32x4*)(T1 + off) = v0; *(f32x4*)(T1 + off + 4) = v1; })
    }
};
struct EpiGateB {
    static constexpr bool PERM = true, AFTER_DRAIN = false;
    const float* T1; const bf16_t* SG; bf16_t* T; int ldc;
    __device__ __forceinline__ void operator()(const f32x4 (&acc)[2][2][4][2], const Unit& u, int wr, int wc, int fr, int fq) const {
        PG8_EPI_WALK({ const int col = u.pn * BM + cl; const size_t off = (size_t)row * ldc + col;
            const u16x8v g = *(const u16x8v*)(SG + off); const f32x4 t0 = *(const f32x4*)(T1 + off), t1 = *(const f32x4*)(T1 + off + 4);
            _Pragma("unroll") for (int e = 0; e < 4; ++e) { v0[e] = t0[e] + v0[e] * bf2f(g[e]); v1[e] = t1[e] + v1[e] * bf2f(g[4 + e]); }
            *(u32x4*)(T + off) = pack8(v0, v1); })
    }
};
struct EpiIn {
    static constexpr bool PERM = true, AFTER_DRAIN = false;
    bf16_t *QA, *KA, *VA, *QKB, *VB, *SBO, *SGA, *SGB; float *LFA, *IPRE, *LFB; float* out; const float *b_fox, *b_mli, *b_mlf;
    int MPr, o_kp, o_vp, o_lfp, o_cvp, o_ks, o_vs, o_lfs, o_cvs; float qscale;
    __device__ __forceinline__ void operator()(const f32x4 (&acc)[2][2][4][2], const Unit& u, int wr, int wc, int fr, int fq) const {
        const int pn = u.pn;
        if (pn == 22) {
            if (wc != 0 || fq > 1) return;
#pragma unroll
            for (int ai = 0; ai < 2; ++ai)
#pragma unroll
                for (int m = 0; m < 4; ++m) { const int row = u.pm * BM + ai * HALF + wr * 64 + m * 16 + fr; f32x4 v0 = acc[ai][0][m][0], v1 = acc[ai][0][m][1];
                    if (fq == 0) {
#pragma unroll
                        for (int e = 0; e < 4; ++e) { v0[e] = logsig(v0[e] + b_fox[e]); v1[e] = logsig(v1[e] + b_fox[4 + e]); }
                        *(f32x4*)(LFA + (size_t)row * 8) = v0; *(f32x4*)(LFA + (size_t)row * 8 + 4) = v1;
                        float* o = out + (row < MPr ? (size_t)o_lfp + (size_t)row * 8 : (size_t)o_lfs + (size_t)(row - MPr) * 8); *(f32x4*)o = v0; *(f32x4*)(o + 4) = v1;
                    } else {
#pragma unroll
                        for (int e = 0; e < 4; ++e) { v0[e] = v0[e] + b_mli[e]; v1[e] = logsig(v1[e] + b_mlf[e]); }
                        *(f32x4*)(IPRE + (size_t)row * 4) = v0; *(f32x4*)(LFB + (size_t)row * 4) = v1;
                    } }
            return;
        }
        bf16_t* dst; int ld, cb, mode;
        if (pn < 2) { dst = QA; ld = 512; cb = pn * BM; mode = 0; }
        else if (pn < 4) { dst = KA; ld = 512; cb = (pn - 2) * BM; mode = 1; }
        else if (pn < 6) { dst = VA; ld = 512; cb = (pn - 4) * BM; mode = 1; }
        else if (pn < 10) { dst = QKB; ld = 1024; cb = (pn - 6) * BM; mode = 2; }
        else if (pn < 12) { dst = VB; ld = 512; cb = (pn - 10) * BM; mode = 3; }
        else if (pn < 14) { dst = SBO; ld = 512; cb = (pn - 12) * BM; mode = 4; }
        else if (pn < 18) { dst = SGA; ld = 1024; cb = (pn - 14) * BM; mode = 4; }
        else { dst = SGB; ld = 1024; cb = (pn - 18) * BM; mode = 4; }
        const int o_p = (pn < 4) ? o_kp : o_vp, o_s = (pn < 4) ? o_ks : o_vs;
        PG8_EPI_WALK({ const int col = cb + cl;
            if (mode == 1) { float* o = out + (row < MPr ? (size_t)o_p + (size_t)row * 512 : (size_t)o_s + (size_t)(row - MPr) * 512) + col; *(f32x4*)o = v0; *(f32x4*)(o + 4) = v1; }
            if (mode == 2) { int j = -1; size_t base = 0;
                if (row < MPr) { const int t = row & 4095; if (t >= 4093) { j = t - 4093; base = (size_t)o_cvp + (size_t)((row >> 12) * 3 + j) * 1024; } }
                else { const int rs = row - MPr, t = rs & 3; if (t >= 1) { j = t - 1; base = (size_t)o_cvs + (size_t)((rs >> 2) * 3 + j) * 1024; } }
                if (j >= 0) { float* o = out + base + col; *(f32x4*)o = v0; *(f32x4*)(o + 4) = v1; } }
            if (mode == 0) { v0 = v0 * qscale; v1 = v1 * qscale; }
            if (mode == 4) { _Pragma("unroll") for (int e = 0; e < 4; ++e) { v0[e] = sigm(v0[e]); v1[e] = sigm(v1[e]); } }
            *(u32x4*)(dst + (size_t)row * ld + col) = pack8(v0, v1); })
    }
};
template <class Epi, class Sched, bool ALIGN_EPI = false, bool SP2 = false>
__device__ __forceinline__ void gemm_phase(PG8_LAS unsigned char* lds, const Gemm g, const Sched& S, const Epi& E) {
    const int tid = threadIdx.x, wid = __builtin_amdgcn_readfirstlane(tid >> 6), lane = tid & 63, wr = wid >> 2, wc = wid & 3, fr = lane & 15, fq = lane >> 4;
    const int K = g.K, nt = K / BK;
    unsigned voffA[2], voffB[2];
#pragma unroll
    for (int i = 0; i < 2; ++i) { int R, C; stage_rc(tid * 16 + i * 8192, R, C); const int Rb = Epi::PERM ? ((R & ~31) + perm32(R & 31)) : R;
        voffA[i] = (unsigned)(R * K + C) * 2u; voffB[i] = (unsigned)(Rb * K + C) * 2u; }
    const size_t kstep = (size_t)(BK * 2);
    const size_t hstep = (size_t)HALF * K * 2;
    const size_t tstep = 2 * hstep;
    const unsigned ldsw = (unsigned)wid * 1024u;
    const int aoff = lds_byte(wr * 64 + fr, fq * 8), boff = lds_byte(wc * 32 + fr, fq * 8);
#define PG8_SA(b, h) (((b) * 2 + (h)) * HTB)
#define PG8_SB(b, h) ((4 + (b) * 2 + (h)) * HTB)
#define PG8_STAGE(bufoff, gbase, voff) do { _Pragma("unroll") for (int _i = 0; _i < 2; ++_i) \
        __builtin_amdgcn_global_load_lds((const unsigned*)((const char*)(gbase) + (voff)[_i]), (PG8_LAS unsigned*)(lds + (bufoff) + ldsw + _i * 8192), 16, 0, 0); } while (0)
#define PG8_LDA(dst, b, h) do { _Pragma("unroll") for (int m = 0; m < 4; ++m) _Pragma("unroll") for (int k = 0; k < 2; ++k) dst[m][k] = *(const PG8_LAS bf16x8*)(lds + PG8_SA(b, h) + aoff + m * 2048 + k * 1024); } while (0)
#define PG8_LDB(dst, b, h) do { _Pragma("unroll") for (int n = 0; n < 2; ++n) _Pragma("unroll") for (int k = 0; k < 2; ++k) dst[n][k] = *(const PG8_LAS bf16x8*)(lds + PG8_SB(b, h) + boff + n * 2048 + k * 1024); } while (0)
#define PG8_MMA(ai, bj, At, Bt) do { __builtin_amdgcn_s_setprio(1); _Pragma("unroll") for (int m = 0; m < 4; ++m) _Pragma("unroll") for (int n = 0; n < 2; ++n) _Pragma("unroll") for (int k = 0; k < 2; ++k) \
        acc[ai][bj][m][n] = __builtin_amdgcn_mfma_f32_16x16x32_bf16(Bt[n][k], At[m][k], acc[ai][bj][m][n], 0, 0, 0); __builtin_amdgcn_s_setprio(0); } while (0)
#define PG8_WAIT_V(n) asm volatile("s_waitcnt vmcnt(" #n ")" ::: "memory")
#define PG8_WAIT_L(n) asm volatile("s_waitcnt lgkmcnt(" #n ")" ::: "memory")
#define PG8_BAR __builtin_amdgcn_s_barrier()
#define PG8_SCHED __builtin_amdgcn_sched_barrier(0)
    Unit cur, nxt; int ui = 0;
    if (!S.next(0, cur)) return;
    f32x4 acc[2][2][4][2];
#pragma unroll
    for (int a = 0; a < 2; ++a)
#pragma unroll
        for (int b = 0; b < 2; ++b)
#pragma unroll
            for (int m = 0; m < 4; ++m)
#pragma unroll
                for (int n = 0; n < 2; ++n) acc[a][b][m][n] = (f32x4){0.f, 0.f, 0.f, 0.f};
    bf16x8 At[4][2], B0[2][2], B1[2][2];
    const char* cA = (const char*)g.A + (size_t)cur.pm * tstep; const char* cB = (const char*)g.Bt + (size_t)cur.pn * tstep;
    S.a_ready(cur);
    if constexpr (SP2) {
        PG8_STAGE(PG8_SB(0, 0), cB, voffB); PG8_STAGE(PG8_SB(0, 1), cB + hstep, voffB); PG8_STAGE(PG8_SA(0, 0), cA, voffA); PG8_STAGE(PG8_SA(0, 1), cA + hstep, voffA);
        if (wr == 1) PG8_BAR;
        PG8_WAIT_V(2); PG8_BAR;
        PG8_STAGE(PG8_SB(1, 0), cB + kstep, voffB); PG8_STAGE(PG8_SA(1, 0), cA + kstep, voffA); PG8_STAGE(PG8_SB(1, 1), cB + hstep + kstep, voffB);
        PG8_WAIT_V(6); PG8_BAR;
    } else {
        PG8_STAGE(PG8_SB(0, 0), cB, voffB); PG8_STAGE(PG8_SA(0, 0), cA, voffA); PG8_STAGE(PG8_SB(0, 1), cB + hstep, voffB); PG8_STAGE(PG8_SA(0, 1), cA + hstep, voffA);
        if (wr == 1) PG8_BAR;
        PG8_WAIT_V(4); PG8_BAR;
        PG8_STAGE(PG8_SB(1, 0), cB + kstep, voffB); PG8_STAGE(PG8_SA(1, 0), cA + kstep, voffA); PG8_STAGE(PG8_SB(1, 1), cB + hstep + kstep, voffB);
        PG8_WAIT_V(6); PG8_BAR;
    }
    for (;;) {
        const bool has_next = S.next(ui + 1, nxt);
        const char* nA = has_next ? (const char*)g.A + (size_t)nxt.pm * tstep : cA; const char* nB = has_next ? (const char*)g.Bt + (size_t)nxt.pn * tstep : cB;
        for (int t = 0; t < nt; t += 2) {
            const bool last = (t == nt - 2);
            const char* a1 = cA + (size_t)(t + 1) * kstep;
            const char* a2 = last ? nA : cA + (size_t)(t + 2) * kstep; const char* b2 = last ? nB : cB + (size_t)(t + 2) * kstep;
            const char* a3 = a2 + kstep; const char* b3 = b2 + kstep;
            if (last && has_next) S.a_ready(nxt);
            if constexpr (SP2) {
            PG8_LDB(B0, 0, 0); PG8_LDB(B1, 0, 1); PG8_SCHED; PG8_LDA(At, 0, 0); PG8_STAGE(PG8_SA(1, 1), a1 + hstep, voffA);
            PG8_WAIT_V(8); PG8_WAIT_L(0); PG8_BAR; PG8_MMA(0, 0, At, B0); PG8_MMA(0, 1, At, B1); PG8_BAR; PG8_SCHED;
            PG8_LDA(At, 0, 1); PG8_STAGE(PG8_SB(0, 0), b2, voffB); PG8_STAGE(PG8_SB(0, 1), b2 + hstep, voffB); PG8_STAGE(PG8_SA(0, 0), a2, voffA);
            PG8_WAIT_V(8); PG8_WAIT_L(0); PG8_BAR; PG8_MMA(1, 0, At, B0); PG8_MMA(1, 1, At, B1); PG8_BAR; PG8_SCHED;
            PG8_LDB(B0, 1, 0); PG8_LDB(B1, 1, 1); PG8_SCHED; PG8_LDA(At, 1, 0); PG8_STAGE(PG8_SA(0, 1), a2 + hstep, voffA);
            PG8_WAIT_V(8); PG8_WAIT_L(0); PG8_BAR; PG8_MMA(0, 0, At, B0); PG8_MMA(0, 1, At, B1); PG8_BAR; PG8_SCHED;
            PG8_LDA(At, 1, 1); PG8_STAGE(PG8_SB(1, 0), b3, voffB); PG8_STAGE(PG8_SB(1, 1), b3 + hstep, voffB); PG8_STAGE(PG8_SA(1, 0), a3, voffA);
            PG8_WAIT_V(8); PG8_WAIT_L(0); PG8_BAR; PG8_MMA(1, 0, At, B0); PG8_MMA(1, 1, At, B1); PG8_BAR; PG8_SCHED;
            } else {
            PG8_LDB(B0, 0, 0); PG8_SCHED; PG8_LDA(At, 0, 0); PG8_STAGE(PG8_SA(1, 1), a1 + hstep, voffA);
            PG8_WAIT_L(8); PG8_BAR; PG8_WAIT_L(0); PG8_MMA(0, 0, At, B0); PG8_BAR; PG8_SCHED;
            PG8_LDB(B1, 0, 1); PG8_STAGE(PG8_SB(0, 0), b2, voffB);
            PG8_BAR; PG8_WAIT_L(0); PG8_MMA(0, 1, At, B1); PG8_BAR;
            PG8_LDA(At, 0, 1); PG8_STAGE(PG8_SA(0, 0), a2, voffA);
            PG8_BAR; PG8_WAIT_L(0); PG8_MMA(1, 0, At, B0); PG8_BAR; PG8_SCHED;
            PG8_STAGE(PG8_SB(0, 1), b2 + hstep, voffB);
            PG8_WAIT_V(6); PG8_BAR; PG8_MMA(1, 1, At, B1); PG8_BAR;
            PG8_LDB(B0, 1, 0); PG8_SCHED; PG8_LDA(At, 1, 0); PG8_STAGE(PG8_SA(0, 1), a2 + hstep, voffA);
            PG8_WAIT_L(8); PG8_BAR; PG8_WAIT_L(0); PG8_MMA(0, 0, At, B0); PG8_BAR; PG8_SCHED;
            PG8_LDB(B1, 1, 1); PG8_STAGE(PG8_SB(1, 0), b3, voffB);
            PG8_BAR; PG8_WAIT_L(0); PG8_MMA(0, 1, At, B1); PG8_BAR;
            PG8_LDA(At, 1, 1); PG8_STAGE(PG8_SA(1, 0), a3, voffA);
            PG8_BAR; PG8_WAIT_L(0); PG8_MMA(1, 0, At, B0); PG8_BAR; PG8_SCHED;
            PG8_STAGE(PG8_SB(1, 1), b3 + hstep, voffB);
            PG8_WAIT_V(6); PG8_BAR; PG8_MMA(1, 1, At, B1); PG8_BAR;
            }
        }
        if constexpr (ALIGN_EPI) { if (wr == 0) PG8_BAR; }
        if constexpr (!Epi::AFTER_DRAIN) { E(acc, cur, wr, wc, fr, fq); S.done(cur); }
        if (!has_next) break;
#pragma unroll
        for (int a = 0; a < 2; ++a)
#pragma unroll
            for (int b = 0; b < 2; ++b)
#pragma unroll
                for (int m = 0; m < 4; ++m)
#pragma unroll
                    for (int n = 0; n < 2; ++n) acc[a][b][m][n] = (f32x4){0.f, 0.f, 0.f, 0.f};
        cur = nxt; cA = nA; cB = nB; ++ui;
        if constexpr (ALIGN_EPI) { if (wr == 1) PG8_BAR; }
    }
    PG8_WAIT_V(0);
    if constexpr (!ALIGN_EPI) { if (wr == 0) PG8_BAR; }
    PG8_BAR;
    if constexpr (Epi::AFTER_DRAIN) { E.fused(acc, cur, wr, wc, fr, fq, lds, wid, lane); S.done(cur); }
#undef PG8_SA
#undef PG8_SB
#undef PG8_STAGE
#undef PG8_LDA
#undef PG8_LDB
#undef PG8_MMA
#undef PG8_WAIT_V
#undef PG8_WAIT_L
#undef PG8_BAR
#undef PG8_SCHED
}
}
#include <hip/hip_bf16.h>
#include <cmath>
namespace attn_body {
using bf16=__hip_bfloat16;
using bf16x8=__attribute__((ext_vector_type(8)))short;
using s16x4=__attribute__((ext_vector_type(4)))short;
using f32x16=__attribute__((ext_vector_type(16)))float;
using u32x4=__attribute__((ext_vector_type(4)))unsigned;
typedef float f32x4_t __attribute__((ext_vector_type(4)));
constexpr int BATCH=4,NHEAD=8,SEQ=4096,D=64,DM=NHEAD*D;
constexpr int NW=8,QBLK=32,QB=QBLK*NW,KVBLK=64,NQB=SEQ/QB;
constexpr int ATTN_PITCH=DM, ATTN_UNIT_ROWS=QB;
__device__ __forceinline__ int crow(int r,int hi){return (r&3)+8*(r>>2)+4*hi;}
#define SBAR() __builtin_amdgcn_sched_barrier(0)
__device__ __forceinline__ void cmask(f32x16&p0,f32x16&p1,int jb,int qrel,int hi){
  const float NEG=-INFINITY; int kb=64*jb+4*hi;
  #pragma unroll
  for(int r=0;r<16;++r){int kv=kb+(r&3)+8*(r>>2); if(kv>qrel)p0[r]=NEG; if(kv+32>qrel)p1[r]=NEG;}
}

constexpr int NSLOT=3, SLOTB=8192;
constexpr int LDS_K=0, LDS_V=NSLOT*SLOTB, LDS_WS=2*NSLOT*SLOTB, LDS_OST=LDS_WS+NW*64*4, LDS_G=LDS_OST+NW*4096, LDS_BYTES=LDS_G+SEQ*4;
constexpr float C2=0.125f*1.4426950408889634f;
__device__ __forceinline__ void glds16(const void*gsrc,unsigned lds_dst){unsigned keep;
  asm volatile("s_mov_b32 %0, m0\n\ts_mov_b32 m0, %2\n\ts_nop 0\n\tglobal_load_lds_dwordx4 %1, off\n\ts_mov_b32 m0, %0":"=&s"(keep):"v"(gsrc),"s"(lds_dst):"memory");}
__device__ __forceinline__ float max3f(float a,float b,float c){float r;asm("v_max3_f32 %0, %1, %2, %3":"=v"(r):"v"(a),"v"(b),"v"(c));return r;}
__device__ __forceinline__ float max2f(float a,float b){float r;asm("v_max_f32_e32 %0, %1, %2":"=v"(r):"v"(a),"v"(b));return r;}
__device__ __forceinline__ float fadd_s(float a,float b){float r;asm("v_add_f32_e32 %0, %1, %2":"=v"(r):"v"(a),"v"(b));return r;}
__device__ __forceinline__ float fsub_s(float a,float b){float r;asm("v_sub_f32_e32 %0, %1, %2":"=v"(r):"v"(a),"v"(b));return r;}
typedef float f32x2_t __attribute__((ext_vector_type(2))); typedef __bf16 bf16x2_t __attribute__((ext_vector_type(2)));
__device__ __forceinline__ unsigned cvtpk_s(float lo,float hi){f32x2_t v={lo,hi};bf16x2_t b=__builtin_convertvector(v,bf16x2_t);return __builtin_bit_cast(unsigned,b);}
#define WAIT_BAR(N) asm volatile("s_waitcnt vmcnt(" #N ") lgkmcnt(0)\n\ts_barrier":::"memory")

__device__ __forceinline__ void qkt(f32x16&p0,f32x16&p1,const char*Kslot,const bf16x8*qr,int r32,int hi){
  const char*kb=Kslot+hi*1024+r32*16;
  #pragma unroll
  for(int d0=0;d0<4;++d0){
    const bf16x8 b0=*reinterpret_cast<const bf16x8*>(kb+d0*2048);
    const bf16x8 b1=*reinterpret_cast<const bf16x8*>(kb+d0*2048+512);
    p0=__builtin_amdgcn_mfma_f32_32x32x16_bf16(b0,qr[d0],p0,0,0,0);p1=__builtin_amdgcn_mfma_f32_32x32x16_bf16(b1,qr[d0],p1,0,0,0);}
}
typedef __attribute__((address_space(3))) const char* lds_cptr;
typedef short v4i16_t __attribute__((ext_vector_type(4)));
__device__ __forceinline__ void kload8(bf16x8*kf,lds_cptr kp){
  kf[0]=*(const __attribute__((address_space(3))) bf16x8*)(kp);      kf[1]=*(const __attribute__((address_space(3))) bf16x8*)(kp+512);
  kf[2]=*(const __attribute__((address_space(3))) bf16x8*)(kp+2048); kf[3]=*(const __attribute__((address_space(3))) bf16x8*)(kp+2560);
  kf[4]=*(const __attribute__((address_space(3))) bf16x8*)(kp+4096); kf[5]=*(const __attribute__((address_space(3))) bf16x8*)(kp+4608);
  kf[6]=*(const __attribute__((address_space(3))) bf16x8*)(kp+6144); kf[7]=*(const __attribute__((address_space(3))) bf16x8*)(kp+6656);
}
__device__ __forceinline__ void kload2(bf16x8*kf,lds_cptr kp,int j){ kf[2*j]=*(const __attribute__((address_space(3))) bf16x8*)(kp+j*2048); kf[2*j+1]=*(const __attribute__((address_space(3))) bf16x8*)(kp+j*2048+512); }
__device__ __forceinline__ s16x4 vtr(lds_cptr p){ return __builtin_bit_cast(s16x4,__builtin_amdgcn_ds_read_tr16_b64_v4i16((__attribute__((address_space(3))) v4i16_t*)p)); }
__device__ __forceinline__ float rowmax(const f32x16&p0,const f32x16&p1){
  float a=max3f(p0[0],p0[1],p1[0]),b=max3f(p0[2],p0[3],p1[1]);a=max3f(a,p1[2],p1[3]);
  #pragma unroll
  for(int r=4;r<16;r+=4){a=max3f(a,p0[r],p0[r+1]);b=max3f(b,p0[r+2],p0[r+3]);a=max3f(a,p1[r],p1[r+1]);b=max3f(b,p1[r+2],p1[r+3]);}
  const float m=max2f(a,b);
  auto rr=__builtin_amdgcn_permlane32_swap(__float_as_uint(m),__float_as_uint(m),false,false);
  return max2f(__uint_as_float(rr[0]),__uint_as_float(rr[1]));
}
__device__ __forceinline__ void pv(f32x16*o,int vb,bf16x8 pa0,bf16x8 pa1,bf16x8 pa2,bf16x8 pa3){
  #pragma unroll
  for(int d0=0;d0<2;++d0){s16x4 lo[4],hi[4];
    #pragma unroll
    for(int ks=0;ks<4;++ks){
      asm volatile("ds_read_b64_tr_b16 %0,%1 offset:%c2":"=&v"(lo[ks]):"v"(vb),"i"(d0*4096+ks*1024):"memory");
      asm volatile("ds_read_b64_tr_b16 %0,%1 offset:%c2":"=&v"(hi[ks]):"v"(vb),"i"(d0*4096+ks*1024+512):"memory");}
    asm volatile("s_waitcnt lgkmcnt(0)":::"memory");SBAR();
    #define PK(k) (bf16x8){lo[k][0],lo[k][1],lo[k][2],lo[k][3],hi[k][0],hi[k][1],hi[k][2],hi[k][3]}
    o[d0]=__builtin_amdgcn_mfma_f32_32x32x16_bf16(pa0,PK(0),o[d0],0,0,0);
    o[d0]=__builtin_amdgcn_mfma_f32_32x32x16_bf16(pa1,PK(1),o[d0],0,0,0);
    o[d0]=__builtin_amdgcn_mfma_f32_32x32x16_bf16(pa2,PK(2),o[d0],0,0,0);
    o[d0]=__builtin_amdgcn_mfma_f32_32x32x16_bf16(pa3,PK(3),o[d0],0,0,0);
    #undef PK
  }
}

#ifndef ATTN_STORE16
#define ATTN_STORE16(p,v) (*(u32x4*)(p)=(v))
#endif
template<int THRL> __device__ __forceinline__ void attn_unit(int b,int h,int qb,const bf16*Q,const bf16*__restrict__ K,const bf16*__restrict__ V,bf16*O,const float*__restrict__ Gn,int t0,char*shm){
  const int tid=threadIdx.x,lane=tid&63,r32=lane&31,hi=lane>>5; const int wid=__builtin_amdgcn_readfirstlane(tid>>6);
  const long rowbase=(long)b*SEQ; const int q0=qb*QB;
  const bf16*Qw=Q+(rowbase+q0+wid*QBLK)*DM+h*D;
  const bf16*Kh=K+(rowbase+(long)t0*KVBLK)*DM+h*D,*Vh=V+(rowbase+(long)t0*KVBLK)*DM+h*D;
  const lds_cptr shm3=(lds_cptr)shm;
  const unsigned lds0=(unsigned)(uintptr_t)shm;
  float*wsf=(float*)(shm+LDS_WS)+wid*64;
  const bf16*ksrc=Kh+(long)lane*DM+wid*8;
  const bf16*vsrc=Vh+(long)(16*(wid&3)+(lane>>2))*DM+(wid>>2)*32+(lane&3)*8;
  const unsigned kdst=lds0+LDS_K+wid*1024, vdst=lds0+LDS_V+wid*1024;
  #define DMA_K(t,slot) glds16(ksrc+(long)(t)*KVBLK*DM,(unsigned)__builtin_amdgcn_readfirstlane(kdst+(slot)))
  #define DMA_V(t,slot) glds16(vsrc+(long)(t)*KVBLK*DM,(unsigned)__builtin_amdgcn_readfirstlane(vdst+(slot)))
  const int vb0=(int)(lds0+LDS_V)+((lane>>4)&1)*32+(lane&3)*8+(4*hi+((lane&15)>>2))*64;
  const char*Kbase=shm+LDS_K; bf16x8 kf[8];
  const lds_cptr kp0=shm3+LDS_K+hi*1024+r32*16; const lds_cptr vp0=shm3+LDS_V+((lane>>4)&1)*32+(lane&3)*8+(4*hi+((lane&15)>>2))*64;
  const int NT=(q0+QB)/KVBLK-t0;
  typedef __attribute__((address_space(3))) float* lds_fptr; typedef __attribute__((address_space(3))) const f32x4_t* lds_f4cptr;
  { const f32x4_t* gsrc4=(const f32x4_t*)(Gn+(long)(b*NHEAD+h)*SEQ+(long)t0*KVBLK); __attribute__((address_space(3))) f32x4_t* gdst4=(__attribute__((address_space(3))) f32x4_t*)(shm3+LDS_G);
    for(int i_=tid;i_<NT*(KVBLK/4);i_+=NW*64) gdst4[i_]=gsrc4[i_]; }
  const __attribute__((address_space(3))) float* gl0=(const __attribute__((address_space(3))) float*)(shm3+LDS_G)+4*hi;
  #define CINIT(C0,C1,t_) do{ const __attribute__((address_space(3))) float* gp_=gl0+(t_)*KVBLK; \
    _Pragma("unroll") for(int g_=0;g_<4;++g_){ const f32x4_t a_=*(lds_f4cptr)(gp_+8*g_); const f32x4_t b_=*(lds_f4cptr)(gp_+32+8*g_); \
      C0[4*g_+0]=nm+a_[0];C0[4*g_+1]=nm+a_[1];C0[4*g_+2]=nm+a_[2];C0[4*g_+3]=nm+a_[3]; C1[4*g_+0]=nm+b_[0];C1[4*g_+1]=nm+b_[1];C1[4*g_+2]=nm+b_[2];C1[4*g_+3]=nm+b_[3]; } }while(0)
  DMA_K(0,0);DMA_V(0,0);DMA_K(1,SLOTB);
  bf16x8 qr[4];
  #pragma unroll
  for(int d0=0;d0<4;++d0)qr[d0]=*reinterpret_cast<const bf16x8*>(&Qw[(long)r32*DM+d0*16+hi*8]);
  float mhat=0.f,l_reg=0.f,nm=0.f;f32x16 o[2];o[0]=f32x16{};o[1]=f32x16{};
  const int qrel=wid*QBLK+r32;
  #define CMASK(P0,P1,t) do{int jb_=(t)-(NT-4); if(jb_>=0)cmask(P0,P1,jb_,qrel,hi);}while(0)
  bool resc=false;
  #define START(P0,P1) do{ const float rm=rowmax(P0,P1); resc=false; \
    { const float dl=rm; mhat=fadd_s(mhat,dl); \
      _Pragma("unroll") for(int r=0;r<16;++r){P0[r]=fsub_s(P0[r],dl);P1[r]=fsub_s(P1[r],dl);} \
      nm=-mhat; } \
    _Pragma("unroll") for(int r=0;r<16;++r)P0[r]=__builtin_amdgcn_exp2f(P0[r]); }while(0)
  #define RESC() do{ if(resc){ asm volatile("s_waitcnt lgkmcnt(0)":::"memory"); \
      _Pragma("unroll") for(int d_=0;d_<2;++d_) _Pragma("unroll") for(int r=0;r<16;++r)o[d_][r]*=wsf[crow(r,hi)]; } }while(0)
  f32x16 pA0,pA1,pB0,pB1;
  int sl_prev=0,sl_cur=0,sl_next=SLOTB;
  #define ROT() do{sl_prev=sl_cur;sl_cur=sl_next;sl_next=(sl_next==(NSLOT-1)*SLOTB)?0:sl_next+SLOTB;}while(0)
  DMA_K(2,2*SLOTB);
  WAIT_BAR(3);
  CINIT(pA0,pA1,0); qkt(pA0,pA1,Kbase,qr,r32,hi);asm volatile("s_nop 15\n\ts_nop 7":"+v"(pA0),"+v"(pA1));CMASK(pA0,pA1,0);
  START(pA0,pA1);
  _Pragma("unroll") for(int r=0;r<16;++r)pA1[r]=__builtin_amdgcn_exp2f(pA1[r]);
  WAIT_BAR(0);
  DMA_K(3,0);DMA_V(1,SLOTB);
  ROT();
  kload8(kf,kp0+sl_cur);
  WAIT_BAR(2);
  s16x4 vlo[8],vhi[8]; u32x4 pw0,pw1,pw2,pw3;
  #define PKW(P,B) cvtpk_s(P[B],P[B+1])
  #define PAF(k) __builtin_bit_cast(bf16x8,pw##k)
  #define VFR(i) (bf16x8){vlo[i][0],vlo[i][1],vlo[i][2],vlo[i][3],vhi[i][0],vhi[i][1],vhi[i][2],vhi[i][3]}
  #define PIN(x) asm volatile("":"+v"(x))
  #define MX3(a,b,c) __builtin_fmaxf(__builtin_fmaxf((a),(b)),(c))
  #define GAPA(MF,A0,A1,A2,A3,W0,W1,PW) do{ MF; sacc+=A0; sacc+=A1; sacc+=A2; sacc+=A3; PIN(sacc); W0; W1; PIN(PW); SBAR(); }while(0)
  #define EX(v) __builtin_amdgcn_exp2f(v)
  #define GAPB(MF,X,B) do{ MF; X[B]=EX(X[B]); X[B+1]=EX(X[B+1]); X[B+2]=EX(X[B+2]); X[B+3]=EX(X[B+3]); PIN(X); SBAR(); }while(0)
  #define VRD(i) do{ vlo[i]=vtr(vp_+(((i)>>2)*4096+((i)&3)*1024)); vhi[i]=vtr(vp_+(((i)>>2)*4096+((i)&3)*1024+512)); }while(0)
  #define KRD(G,j) do{ if(G){ kload2(kf,kp0+sl_next,j); SBAR(); } }while(0)
  #define STEP(C0,C1,P0,P1,t,GK,GV,GL) do{ SBAR(); \
    const lds_cptr vp_=vp0+sl_prev; \
    CINIT(C0,C1,t); SBAR(); \
    VRD(0); SBAR(); float sacc=(P0[0]+P0[1]); \
    GAPA(C0=__builtin_amdgcn_mfma_f32_32x32x16_bf16(kf[0],qr[0],C0,0,0,0), P0[2],P0[3],P0[4],P0[5],     pw0[0]=PKW(P0,0), pw0[1]=PKW(P0,2), pw0); \
    VRD(4); SBAR(); GAPA(C1=__builtin_amdgcn_mfma_f32_32x32x16_bf16(kf[1],qr[0],C1,0,0,0), P0[6],P0[7],P0[8],P0[9],     pw0[2]=PKW(P0,4), pw0[3]=PKW(P0,6), pw0); \
    VRD(1); SBAR(); GAPA(C0=__builtin_amdgcn_mfma_f32_32x32x16_bf16(kf[2],qr[1],C0,0,0,0),   P0[10],P0[11],P0[12],P0[13], pw1[0]=PKW(P0,8), pw1[1]=PKW(P0,10), pw1); \
    VRD(5); SBAR(); GAPA(C1=__builtin_amdgcn_mfma_f32_32x32x16_bf16(kf[3],qr[1],C1,0,0,0),   P0[14],P0[15],P1[0],P1[1],   pw1[2]=PKW(P0,12),pw1[3]=PKW(P0,14), pw1); \
    VRD(2); SBAR(); GAPA(C0=__builtin_amdgcn_mfma_f32_32x32x16_bf16(kf[4],qr[2],C0,0,0,0),   P1[2],P1[3],P1[4],P1[5],     pw2[0]=PKW(P1,0), pw2[1]=PKW(P1,2), pw2); \
    VRD(6); SBAR(); GAPA(C1=__builtin_amdgcn_mfma_f32_32x32x16_bf16(kf[5],qr[2],C1,0,0,0),   P1[6],P1[7],P1[8],P1[9],     pw2[2]=PKW(P1,4), pw2[3]=PKW(P1,6), pw2); \
    VRD(3); SBAR(); GAPA(C0=__builtin_amdgcn_mfma_f32_32x32x16_bf16(kf[6],qr[3],C0,0,0,0),   P1[10],P1[11],P1[12],P1[13], pw3[0]=PKW(P1,8), pw3[1]=PKW(P1,10), pw3); \
    VRD(7); SBAR(); GAPA(C1=__builtin_amdgcn_mfma_f32_32x32x16_bf16(kf[7],qr[3],C1,0,0,0),   P1[14],P1[15],0.f,0.f,       pw3[2]=PKW(P1,12),pw3[3]=PKW(P1,14), pw3); \
    l_reg+=sacc; \
    if(GK){DMA_K((t)+3,sl_cur);} if(GV){DMA_V((t)+1,sl_next);} \
    CMASK(C0,C1,t); \
    { float a=MX3(C0[0],C0[1],C1[0]),b=MX3(C0[2],C0[3],C1[1]); a=MX3(a,C1[2],C1[3]); \
      _Pragma("unroll") for(int r=4;r<16;r+=4){a=MX3(a,C0[r],C0[r+1]);b=MX3(b,C0[r+2],C0[r+3]);a=MX3(a,C1[r],C1[r+1]);b=MX3(b,C1[r+2],C1[r+3]);} \
      float rm=__builtin_fmaxf(a,b); { auto rr=__builtin_amdgcn_permlane32_swap(__float_as_uint(rm),__float_as_uint(rm),false,false); rm=__builtin_fmaxf(__uint_as_float(rr[0]),__uint_as_float(rr[1])); } \
      resc=false; \
      if(__builtin_expect(__any(rm>(float)THRL),0)){ const float dl=__builtin_fmaxf(rm,0.f); mhat+=dl; \
        _Pragma("unroll") for(int r=0;r<16;++r){C0[r]-=dl;C1[r]-=dl;} \
        nm=-mhat; \
        const float f=__builtin_amdgcn_exp2f(-dl); l_reg*=f; if(hi==0)wsf[r32]=f; resc=true; } } \
    SBAR(); \
    GAPB(o[0]=__builtin_amdgcn_mfma_f32_32x32x16_bf16(PAF(0),VFR(0),o[0],0,0,0), C0,0); \
    GAPB(o[1]=__builtin_amdgcn_mfma_f32_32x32x16_bf16(PAF(0),VFR(4),o[1],0,0,0), C0,4); \
    KRD(GL,0); GAPB(o[0]=__builtin_amdgcn_mfma_f32_32x32x16_bf16(PAF(1),VFR(1),o[0],0,0,0), C0,8); \
    KRD(GL,1); GAPB(o[1]=__builtin_amdgcn_mfma_f32_32x32x16_bf16(PAF(1),VFR(5),o[1],0,0,0), C0,12); \
    KRD(GL,2); GAPB(o[0]=__builtin_amdgcn_mfma_f32_32x32x16_bf16(PAF(2),VFR(2),o[0],0,0,0), C1,0); \
    KRD(GL,3); GAPB(o[1]=__builtin_amdgcn_mfma_f32_32x32x16_bf16(PAF(2),VFR(6),o[1],0,0,0), C1,4); \
    GAPB(o[0]=__builtin_amdgcn_mfma_f32_32x32x16_bf16(PAF(3),VFR(3),o[0],0,0,0), C1,8); \
    GAPB(o[1]=__builtin_amdgcn_mfma_f32_32x32x16_bf16(PAF(3),VFR(7),o[1],0,0,0), C1,12); \
    }while(0)
  int t=1;
  #undef CMASK
  #define CMASK(P0,P1,t) do{}while(0)
  for(;t+5<NT;t+=2){
    STEP(pB0,pB1,pA0,pA1,t,true,true,true);     WAIT_BAR(2); RESC(); ROT();
    STEP(pA0,pA1,pB0,pB1,t+1,true,true,true);   WAIT_BAR(2); RESC(); ROT();
  }
  #undef CMASK
  #define CMASK(P0,P1,t) do{int jb_=(t)-(NT-4); if(jb_>=0)cmask(P0,P1,jb_,qrel,hi);}while(0)
  #define ENDW(tt) do{ if((tt)+3<NT){WAIT_BAR(2);} else if((tt)+2<NT){WAIT_BAR(1);} else {WAIT_BAR(0);} }while(0)
  for(;t+1<NT;t+=2){
    STEP(pB0,pB1,pA0,pA1,t,(t+3<NT),(t+1<NT),(t+1<NT));       ENDW(t);   RESC(); ROT();
    STEP(pA0,pA1,pB0,pB1,t+1,(t+4<NT),(t+2<NT),(t+2<NT));     ENDW(t+1); RESC(); ROT();
  }
  STEP(pB0,pB1,pA0,pA1,NT-1,false,false,false); RESC();
  { float sacc=pB0[0]+pB0[1]; _Pragma("unroll") for(int r=2;r<16;++r)sacc+=pB0[r]; _Pragma("unroll") for(int r=0;r<16;++r)sacc+=pB1[r]; l_reg+=sacc;
    pw0=(u32x4){PKW(pB0,0),PKW(pB0,2),PKW(pB0,4),PKW(pB0,6)};pw1=(u32x4){PKW(pB0,8),PKW(pB0,10),PKW(pB0,12),PKW(pB0,14)};pw2=(u32x4){PKW(pB1,0),PKW(pB1,2),PKW(pB1,4),PKW(pB1,6)};pw3=(u32x4){PKW(pB1,8),PKW(pB1,10),PKW(pB1,12),PKW(pB1,14)};
    SBAR(); pv(o,vb0+sl_cur,PAF(0),PAF(1),PAF(2),PAF(3)); }
  #undef PKW
  #undef PAF
  #undef VFR
  #undef PIN
  #undef MX3
  #undef GAPA
  #undef GAPB
  #undef EX
  #undef VRD
  #undef KRD
  #undef STEP
  #undef ENDW
  {auto rr=__builtin_amdgcn_permlane32_swap(__float_as_uint(l_reg),__float_as_uint(l_reg),false,false);l_reg=__uint_as_float(rr[0])+__uint_as_float(rr[1]);}
  if(hi==0)wsf[32+r32]=l_reg;asm volatile("s_waitcnt lgkmcnt(0)":::"memory");
  float rli[16];
  #pragma unroll
  for(int r=0;r<16;++r)rli[r]=__builtin_amdgcn_rcpf(wsf[32+crow(r,hi)]);
  bf16*Ow=O+(rowbase+q0+wid*QBLK)*DM+h*D;
  { bf16*stg=(bf16*)(shm+LDS_OST)+wid*2048;
    #pragma unroll
    for(int r=0;r<16;++r){const int orow=crow(r,hi);
      #pragma unroll
      for(int d0=0;d0<2;++d0)stg[orow*64+d0*32+r32]=__float2bfloat16(o[d0][r]*rli[r]);}
    asm volatile("s_waitcnt lgkmcnt(0)":::"memory");
    #pragma unroll
    for(int i=0;i<4;++i){const int row=i*8+(lane>>3),ch=lane&7; const u32x4 v=*(const u32x4*)(stg+row*64+ch*8); ATTN_STORE16(Ow+(long)row*DM+ch*8,v);} }
  asm volatile("s_waitcnt lgkmcnt(0)\n\ts_barrier":::"memory");
  #undef DMA_K
  #undef DMA_V
  #undef CMASK
  #undef START
  #undef RESC
  #undef ROT
  #undef CINIT
}
constexpr int ATTN_LDS_BYTES=LDS_BYTES;
struct AttnTensors { const bf16* Q; const bf16* K; const bf16* V; bf16* O; const float* Gn; const int* T0; };
struct AttnUnit { int bh; int qb; };
struct StaticOrder {
  int vcu, G;
  __device__ __forceinline__ explicit StaticOrder(int grid,int vcu_):vcu(vcu_),G(grid){}
  __device__ __forceinline__ bool next(int i,AttnUnit&u)const{ const int v=vcu+(i>>1)*G; if(v>=BATCH*NHEAD*8)return false; const int s=v&7; u.bh=v>>3; u.qb=(i&1)?15-s:s; return true; }
  __device__ __forceinline__ void a_ready(const AttnUnit&)const{}
  __device__ __forceinline__ void done(const AttnUnit&)const{}
};
template<class Sched,int THRL=8> __device__ __forceinline__ void attn_phase(char*lds,const AttnTensors&T,const Sched&S){
  AttnUnit u;
  for(int i=0;S.next(i,u);++i){ S.a_ready(u); attn_unit<THRL>(u.bh/NHEAD,u.bh%NHEAD,u.qb,T.Q,T.K,T.V,T.O,T.Gn,__builtin_amdgcn_readfirstlane(T.T0[u.bh*(SEQ/QB)+u.qb]),lds); S.done(u); }
}
#undef SBAR
#undef WAIT_BAR
}
#define GAS __attribute__((address_space(1)))
#define LAS __attribute__((address_space(3)))
typedef unsigned short bf16;
typedef unsigned v4u __attribute__((ext_vector_type(4)));
typedef float f32x4 __attribute__((ext_vector_type(4)));
typedef short bf16x8 __attribute__((ext_vector_type(8)));
typedef GAS unsigned gu32;
typedef GAS unsigned long long gu64;
#define RLX_AGENT __ATOMIC_RELAXED, __HIP_MEMORY_SCOPE_AGENT
#define LDS_WAIT() asm volatile("s_waitcnt lgkmcnt(0)" ::: "memory")
#define VM_WAIT() asm volatile("s_waitcnt vmcnt(0)" ::: "memory")
__device__ __forceinline__ unsigned long long rt() { return __builtin_amdgcn_s_memrealtime(); }
__device__ __forceinline__ unsigned f2bf(float f) { unsigned u = __builtin_bit_cast(unsigned, f); return (u + 0x7fffu + ((u >> 16) & 1u)) >> 16; }
__device__ __forceinline__ unsigned pk2(float lo, float hi) { return f2bf(lo) | (f2bf(hi) << 16); }

#define XB_TMO      128
#define XB_XCNT(j)  (256  + 64 * (j))
#define XB_XSUB(j)  (1280 + 64 * (j))
#define XB_XGEN(j)  (2304 + 64 * (j))
#define XB_TOP      3328
#define XB_TOPGEN   3392
#define XCD_BAR_WORDS 3456
#define XB_SPIN_CAP (1u << 18)

__device__ __forceinline__ unsigned xb_ld(unsigned* p)              { return __hip_atomic_load(p, __ATOMIC_RELAXED, __HIP_MEMORY_SCOPE_AGENT); }
__device__ __forceinline__ unsigned xb_add(unsigned* p, unsigned v) { return __hip_atomic_fetch_add(p, v, __ATOMIC_RELAXED, __HIP_MEMORY_SCOPE_AGENT); }
__device__ __forceinline__ unsigned xb_xcc_id() { return (unsigned)__builtin_amdgcn_s_getreg((3 << 11) | 20) & 0xFu; }
#define XB_SPIN(cond, bar) do { unsigned _sp = 0; while (cond) { __builtin_amdgcn_s_sleep(1); \
    if ((++_sp & 255u) == 0u) { if (xb_ld(&(bar)[XB_TMO])) break; if (_sp > XB_SPIN_CAP) { atomicAdd(&(bar)[XB_TMO], 1u); break; } } } } while (0)

struct XcdBarrier {
    unsigned* bar; unsigned x;
    volatile LAS unsigned* st;
};

__device__ __forceinline__ XcdBarrier xcd_barrier_post(unsigned* bar, volatile LAS unsigned* st) {
    XcdBarrier b; b.bar = bar; b.x = xb_xcc_id(); b.st = st;
    if (threadIdx.x == 0) (void)xb_add(&bar[XB_XCNT(b.x)], 1u);
    return b;
}
__device__ __forceinline__ void xcd_barrier_complete(unsigned* bar, unsigned x, unsigned& nloc, unsigned& nx) {
    const unsigned G = gridDim.x * gridDim.y * gridDim.z;
    unsigned sum, cnt, mine, sp = 0u;
    for (;;) {
        sum = 0u; cnt = 0u; mine = 0u;
#pragma unroll
        for (unsigned j = 0; j < 16; ++j) { const unsigned c = xb_ld(&bar[XB_XCNT(j)]); sum += c; cnt += (c > 0u) ? 1u : 0u; mine = (j == x) ? c : mine; }
        if (sum == G) break;
        __builtin_amdgcn_s_sleep(1);
        if ((++sp & 255u) == 0u) { if (xb_ld(&bar[XB_TMO])) break; if (sp > XB_SPIN_CAP) { atomicAdd(&bar[XB_TMO], 1u); break; } }
    }
    nloc = mine > 0u ? mine : 1u; nx = cnt > 0u ? cnt : 1u;
}

__device__ __forceinline__ void xcd_barrier(const XcdBarrier& b) {
    asm volatile("s_waitcnt vmcnt(0)" ::: "memory");
    __syncthreads();
    if (threadIdx.x == 0) {
        unsigned* bar = b.bar;
        __builtin_amdgcn_s_waitcnt(0);
        unsigned nloc = b.st[0], nx = b.st[1];
        if (nloc == 0u) { xcd_barrier_complete(bar, b.x, nloc, nx); b.st[0] = nloc; b.st[1] = nx; }
        const unsigned old = xb_add(&bar[XB_XSUB(b.x)], 1u);
        const unsigned gen = old / nloc;
        if (old + 1u == (gen + 1u) * nloc) {
            __builtin_amdgcn_fence(__ATOMIC_RELEASE, "agent");
            asm volatile("s_waitcnt vmcnt(0)" ::: "memory");
            const unsigned og = xb_add(&bar[XB_TOP], 1u);
            const unsigned tg = og / nx;
            if (og + 1u == (tg + 1u) * nx) xb_add(&bar[XB_TOPGEN], 1u);
            else XB_SPIN(xb_ld(&bar[XB_TOPGEN]) == tg, bar);
            __builtin_amdgcn_fence(__ATOMIC_ACQUIRE, "agent");
            xb_add(&bar[XB_XGEN(b.x)], 1u);
            asm volatile("s_waitcnt vmcnt(0)" ::: "memory");
        } else {
            XB_SPIN(xb_ld(&bar[XB_XGEN(b.x)]) == gen, bar);
            __builtin_amdgcn_fence(__ATOMIC_ACQUIRE, "agent");
            asm volatile("s_waitcnt vmcnt(0)" ::: "memory");
        }
    }
    __syncthreads();
}
constexpr int NWAVES = 8;
#ifndef MK_N_LAUNCHES
#define MK_N_LAUNCHES 1
#endif
constexpr int NPH = 13;
constexpr bool ONE_LAUNCH = (MK_N_LAUNCHES == 1);

constexpr int D = 1024, MP = 16384, MS = 512, M = MP + MS, SEQ = 4096, NB = 4, DB = 128, DSEQ = 4;
constexpr int AH = 8, AW = 512, BHN = 4, BHD = 128, BW = 512, FF = 4096, NIN = 5648, NINP = 5888, NMODC = 6144;
constexpr int NPAGES = 16, PAGE = 128;
constexpr float RMS_EPS = 1e-6f, LOG2E = 1.4426950408889634f;
constexpr int O_Y = 0;
constexpr int O_KP = O_Y + M * D, O_VP = O_KP + MP * AW, O_LFP = O_VP + MP * AW, O_CP = O_LFP + MP * AH, O_NP = O_CP + NB * BHN * BHD * BHD, O_MP = O_NP + NB * BHN * BHD,
              O_CVP = O_MP + NB * BHN, O_KS = O_CVP + NB * 3 * 1024, O_VS = O_KS + MS * AW, O_LFS = O_VS + MS * AW, O_CS = O_LFS + MS * AH, O_NS = O_CS + DB * BHN * BHD * BHD,
              O_MS = O_NS + DB * BHN * BHD, O_CVS = O_MS + DB * BHN, O_END = O_CVS + DB * 3 * 1024;
static_assert(O_END == 43862544, "output size");

constexpr size_t MiB = 1u << 20;
constexpr size_t WS_CTL = 0, CTL_ZERO_BYTES = 1 * MiB;
constexpr size_t WS_WIN = 2 * MiB, WS_WPA = 14 * MiB, WS_WPB = 15 * MiB, WS_WOUT = 16 * MiB, WS_WUP = 18 * MiB, WS_WDN = 26 * MiB, WS_WADA = 34 * MiB, WS_SC = 46 * MiB, WS_MOD = 47 * MiB;
constexpr size_t WS_XN = 54 * MiB, WS_QA = 88 * MiB, WS_KA = 105 * MiB, WS_VA = 122 * MiB, WS_QKB = 139 * MiB, WS_VB = 172 * MiB, WS_SBO = 189 * MiB, WS_SGA = 206 * MiB, WS_SGB = 239 * MiB;
constexpr size_t WS_LFA = 272 * MiB, WS_IPRE = 273 * MiB, WS_LFB = 274 * MiB, WS_GN = 275 * MiB, WS_OA = 276 * MiB, WS_HB = 293 * MiB, WS_MQ = 310 * MiB, WS_MK = 327 * MiB;
constexpr size_t WS_KVT = 344 * MiB, WS_KN = 408 * MiB, WS_BLML = 409 * MiB, WS_CST = 410 * MiB, WS_NST = 442 * MiB, WS_MST = 443 * MiB;
constexpr size_t WS_T1 = 444 * MiB, WS_T = 510 * MiB, WS_Y = 544 * MiB, WS_U = 610 * MiB, WS_PART = 742 * MiB, WS_SCR = 760 * MiB, WS_PM = 792 * MiB, WS_QN2 = 793 * MiB, WS_KN2 = 794 * MiB, WS_T0 = 795 * MiB, WS_END = 796 * MiB;
static_assert(WS_WIN + (size_t)NINP * D * 2 <= WS_WPA && WS_WADA + (size_t)NMODC * D * 2 <= WS_SC && WS_MOD + 256 * (size_t)NMODC * 4 <= WS_XN && WS_XN + (size_t)M * D * 2 <= WS_QA, "ws map 1");
static_assert(WS_QA + (size_t)M * 512 * 2 <= WS_KA && WS_QKB + (size_t)M * 1024 * 2 <= WS_VB && WS_SGA + (size_t)M * 1024 * 2 <= WS_SGB && WS_SGB + (size_t)M * 1024 * 2 <= WS_LFA, "ws map 2");
static_assert(WS_KVT + 1024 * (size_t)65536 <= WS_KN && WS_CST + 1024 * (size_t)32768 <= WS_NST && WS_T1 + (size_t)M * D * 4 <= WS_T && WS_T + (size_t)M * D * 2 <= WS_Y && WS_Y + (size_t)M * D * 4 <= WS_U, "ws map 3");
static_assert(WS_U + (size_t)M * FF * 2 <= WS_PART && WS_PART + (size_t)DB * NPAGES * AH * 4 * 68 * 4 <= WS_SCR && WS_SCR + (size_t)DB * NPAGES * AH * 512 * 4 <= WS_PM, "ws map 4");
constexpr int CW_TMO = 0, CW_CODE = 1, CW_BAR = 4096;
constexpr int PART_STRIDE = 68;

constexpr int RING_OFF = 0, RING_BYTES = 131072;
constexpr int LDSCTL_OFF = RING_BYTES, MISC_OFF = LDSCTL_OFF + 320;
constexpr int LDS_BYTES = 147456;
static_assert(MISC_OFF + 128 <= LDS_BYTES, "LDS map");
struct Ctx {
    LAS unsigned char* lds; gu32* ctl; int tid, lane, wave, vcu, G;
    const float *x_prompt, *x_sample, *cache_k, *cache_v, *cache_logf; const int* page_table;
    const float *state_C, *state_n, *state_m, *state_conv, *c_prompt, *c_sample, *w_ada, *b_ada, *g_pre_mix, *g_post_mix, *g_pre_mlp, *g_post_mlp,
                *w_in, *b_fox_f, *b_ml_i, *b_ml_f, *conv_w, *conv_b, *w_proj_a, *w_proj_b, *w_out, *w_up, *w_down;
    float* out; unsigned char* ws;
};
typedef short s16x4v __attribute__((ext_vector_type(4)));
typedef unsigned short u16x8 __attribute__((ext_vector_type(8)));
typedef unsigned short u16x4 __attribute__((ext_vector_type(4)));
typedef unsigned u32x2 __attribute__((ext_vector_type(2)));
#define MFMA16(a, b, c) __builtin_amdgcn_mfma_f32_16x16x32_bf16((a), (b), (c), 0, 0, 0)
__device__ __forceinline__ float bf2f(unsigned short b) { return __uint_as_float(((unsigned)b) << 16); }
__device__ __forceinline__ float sigm(float x) { return 1.0f / (1.0f + __expf(-x)); }
__device__ __forceinline__ float siluf(float x) { return x / (1.0f + __expf(-x)); }
__device__ __forceinline__ float wave_sum(float v) {
#pragma unroll
    for (int o = 1; o < 64; o <<= 1) v += __shfl_xor(v, o);
    return v;
}
__device__ __forceinline__ float wave_max(float v) {
#pragma unroll
    for (int o = 1; o < 64; o <<= 1) v = fmaxf(v, __shfl_xor(v, o));
    return v;
}
__device__ __forceinline__ float wave_scan_add(float v, int lane) {
#pragma unroll
    for (int o = 1; o < 64; o <<= 1) { const float t = __shfl_up(v, o); if (lane >= o) v += t; }
    return v;
}
__device__ __forceinline__ float wave_scan_max(float v, int lane) {
#pragma unroll
    for (int o = 1; o < 64; o <<= 1) { const float t = __shfl_up(v, o); if (lane >= o) v = fmaxf(v, t); }
    return v;
}

__device__ __forceinline__ void tr_item(const float* W, int ldw, int k0, int c0, bf16* WT, int ldt, int r0, LAS float* scr, int lane, bool gate) {
    const int n_ = lane & 31;
#pragma unroll 8
    for (int i = 0; i < 32; ++i) { const int kk = 2 * i + (lane >> 5);
        float v;
        if (gate) { const int sc = n_ < 8 ? 1536 + n_ : 3072 + n_; v = n_ < 16 ? W[(size_t)(k0 + kk) * ldw + sc] : 0.f; }
        else v = W[(size_t)(k0 + kk) * ldw + c0 + n_];
        scr[kk * 33 + n_] = v; }
    LDS_WAIT(); asm volatile("" ::: "memory");
    const int c = lane & 7;
#pragma unroll
    for (int j = 0; j < 4; ++j) { const int n = (lane >> 3) + 8 * j; const LAS float* s = scr + (8 * c) * 33 + n;
        v4u o; o.x = pk2(s[0 * 33], s[1 * 33]); o.y = pk2(s[2 * 33], s[3 * 33]); o.z = pk2(s[4 * 33], s[5 * 33]); o.w = pk2(s[6 * 33], s[7 * 33]);
        *(GAS v4u*)(WT + (size_t)(r0 + n) * ldt + k0 + 8 * c) = o; }
    LDS_WAIT(); asm volatile("" ::: "memory");
}
__device__ __forceinline__ void p0_prologue(const Ctx& C) {
    LAS float* scr = (LAS float*)(C.lds + RING_OFF + C.wave * 16384);
    const int gw = C.vcu * NWAVES + C.wave, NGW = C.G * NWAVES, lane = C.lane;
    bf16* WIN = (bf16*)(C.ws + WS_WIN); bf16* WPA = (bf16*)(C.ws + WS_WPA); bf16* WPB = (bf16*)(C.ws + WS_WPB); bf16* WOUT = (bf16*)(C.ws + WS_WOUT);
    bf16* WUP = (bf16*)(C.ws + WS_WUP); bf16* WDN = (bf16*)(C.ws + WS_WDN); bf16* WADA = (bf16*)(C.ws + WS_WADA); bf16* SC = (bf16*)(C.ws + WS_SC);
    constexpr int I_IN = 16 * 176, I_G = 16, I_PA = 8 * 32, I_PB = 8 * 32, I_OUT = 16 * 32, I_UP = 16 * 128, I_DN = 64 * 32, I_ADA = 16 * 192;
    constexpr int NITEMS = I_IN + I_G + I_PA + I_PB + I_OUT + I_UP + I_DN + I_ADA;
    for (int it = gw; it < NITEMS; it += NGW) {
        int r = it;
        if (r < I_IN) { const int kb = r / 176, nb = r % 176, n0 = 32 * nb, c0 = n0 + (n0 >= 3072 ? 16 : (n0 >= 1536 ? 8 : 0)); tr_item(C.w_in, NIN, 64 * kb, c0, WIN, D, n0, scr, lane, false); continue; } r -= I_IN;
        if (r < I_G) { tr_item(C.w_in, NIN, 64 * r, 0, WIN, D, 5632, scr, lane, true); continue; } r -= I_G;
        if (r < I_PA) { tr_item(C.w_proj_a, D, 64 * (r / 32), 32 * (r % 32), WPA, AW, 32 * (r % 32), scr, lane, false); continue; } r -= I_PA;
        if (r < I_PB) { tr_item(C.w_proj_b, D, 64 * (r / 32), 32 * (r % 32), WPB, BW, 32 * (r % 32), scr, lane, false); continue; } r -= I_PB;
        if (r < I_OUT) { tr_item(C.w_out, D, 64 * (r / 32), 32 * (r % 32), WOUT, D, 32 * (r % 32), scr, lane, false); continue; } r -= I_OUT;
        if (r < I_UP) { tr_item(C.w_up, FF, 64 * (r / 128), 32 * (r % 128), WUP, D, 32 * (r % 128), scr, lane, false); continue; } r -= I_UP;
        if (r < I_DN) { tr_item(C.w_down, D, 64 * (r / 32), 32 * (r % 32), WDN, FF, 32 * (r % 32), scr, lane, false); continue; } r -= I_DN;
        tr_item(C.w_ada, NMODC, 64 * (r / 192), 32 * (r % 192), WADA, D, 32 * (r % 192), scr, lane, false);
    }
    for (int i = C.vcu * (NWAVES * 64) + C.tid; i < 28672; i += C.G * NWAVES * 64) ((GAS v4u*)(WIN + (size_t)5664 * D))[i] = (v4u){0u, 0u, 0u, 0u};
    for (int r = gw; r < 256; r += NGW) {
        const float* src = r < NB ? C.c_prompt + (size_t)r * D : (r < NB + DB ? C.c_sample + (size_t)(r - NB) * D : nullptr);
#pragma unroll
        for (int j = 0; j < 4; ++j) { f32x4 v = (f32x4){0.f, 0.f, 0.f, 0.f}; if (src) v = ((const f32x4*)src)[lane + 64 * j];
            u32x2 o; o.x = pk2(src ? siluf(v.x) : 0.f, src ? siluf(v.y) : 0.f); o.y = pk2(src ? siluf(v.z) : 0.f, src ? siluf(v.w) : 0.f);
            *(u32x2*)(SC + (size_t)r * D + 4 * (lane + 64 * j)) = o; }
    }
}

__device__ __forceinline__ void p2_norm1(const Ctx& C) {
    const int gw = C.vcu * NWAVES + C.wave, NGW = C.G * NWAVES, lane = C.lane;
    const float* MOD = (const float*)(C.ws + WS_MOD); bf16* XN = (bf16*)(C.ws + WS_XN);
    for (int m = gw; m < M; m += NGW) {
        const float* xr = m < MP ? C.x_prompt + (size_t)m * D : C.x_sample + (size_t)(m - MP) * D;
        const int mr = m < MP ? (m >> 12) : NB + ((m - MP) >> 2);
        const float* mod = MOD + (size_t)mr * NMODC;
        f32x4 v[4]; float s = 0.f;
#pragma unroll
        for (int j = 0; j < 4; ++j) { v[j] = ((const f32x4*)xr)[lane + 64 * j]; s += (v[j].x * v[j].x + v[j].y * v[j].y) + (v[j].z * v[j].z + v[j].w * v[j].w); }
        const float r = 1.0f / sqrtf(wave_sum(s) * (1.0f / D) + RMS_EPS);
#pragma unroll
        for (int j = 0; j < 4; ++j) { const int c = 4 * (lane + 64 * j);
            const f32x4 g = *(const f32x4*)(C.g_pre_mix + c), sc = *(const f32x4*)(mod + 1024 + c), sh = *(const f32x4*)(mod + c);
            const f32x4 h = (v[j] * r) * g * (sc + 1.0f) + sh;
            u32x2 o; o.x = pk2(h.x, h.y); o.y = pk2(h.z, h.w); *(u32x2*)(XN + (size_t)m * D + c) = o; }
    }
}

__device__ __forceinline__ void p9_norm2(const Ctx& C) {
    const int gw = C.vcu * NWAVES + C.wave, NGW = C.G * NWAVES, lane = C.lane;
    const float* MOD = (const float*)(C.ws + WS_MOD); bf16* XN = (bf16*)(C.ws + WS_XN); const float* Y = (const float*)(C.ws + WS_Y);
    for (int m = gw; m < M; m += NGW) {
        const float* xr = m < MP ? C.x_prompt + (size_t)m * D : C.x_sample + (size_t)(m - MP) * D;
        const int mr = m < MP ? (m >> 12) : NB + ((m - MP) >> 2);
        const float* mod = MOD + (size_t)mr * NMODC;
        f32x4 y[4]; float s = 0.f;
#pragma unroll
        for (int j = 0; j < 4; ++j) { y[j] = ((const f32x4*)(Y + (size_t)m * D))[lane + 64 * j]; s += (y[j].x * y[j].x + y[j].y * y[j].y) + (y[j].z * y[j].z + y[j].w * y[j].w); }
        const float r = 1.0f / sqrtf(wave_sum(s) * (1.0f / D) + RMS_EPS);
        float s2 = 0.f;
#pragma unroll
        for (int j = 0; j < 4; ++j) { const int c = 4 * (lane + 64 * j);
            const f32x4 g = *(const f32x4*)(C.g_post_mix + c), gt = *(const f32x4*)(mod + 2048 + c), x = ((const f32x4*)xr)[lane + 64 * j];
            y[j] = x + gt * ((y[j] * r) * g);
            *(f32x4*)(C.out + O_Y + (size_t)m * D + c) = y[j];
            s2 += (y[j].x * y[j].x + y[j].y * y[j].y) + (y[j].z * y[j].z + y[j].w * y[j].w); }
        const float r2 = 1.0f / sqrtf(wave_sum(s2) * (1.0f / D) + RMS_EPS);
#pragma unroll
        for (int j = 0; j < 4; ++j) { const int c = 4 * (lane + 64 * j);
            const f32x4 g = *(const f32x4*)(C.g_pre_mlp + c), sc = *(const f32x4*)(mod + 4096 + c), sh = *(const f32x4*)(mod + 3072 + c);
            const f32x4 h = (y[j] * r2) * g * (sc + 1.0f) + sh;
            u32x2 o; o.x = pk2(h.x, h.y); o.y = pk2(h.z, h.w); *(u32x2*)(XN + (size_t)m * D + c) = o; }
    }
}
__device__ __forceinline__ void p12_final(const Ctx& C) {
    const int gw = C.vcu * NWAVES + C.wave, NGW = C.G * NWAVES, lane = C.lane;
    const float* MOD = (const float*)(C.ws + WS_MOD); const float* Y = (const float*)(C.ws + WS_Y);
    for (int m = gw; m < M; m += NGW) {
        const int mr = m < MP ? (m >> 12) : NB + ((m - MP) >> 2);
        const float* mod = MOD + (size_t)mr * NMODC;
        f32x4 y[4]; float s = 0.f;
#pragma unroll
        for (int j = 0; j < 4; ++j) { y[j] = ((const f32x4*)(Y + (size_t)m * D))[lane + 64 * j]; s += (y[j].x * y[j].x + y[j].y * y[j].y) + (y[j].z * y[j].z + y[j].w * y[j].w); }
        const float r = 1.0f / sqrtf(wave_sum(s) * (1.0f / D) + RMS_EPS);
#pragma unroll
        for (int j = 0; j < 4; ++j) { const int c = 4 * (lane + 64 * j);
            const f32x4 g = *(const f32x4*)(C.g_post_mlp + c), gt = *(const f32x4*)(mod + 5120 + c);
            float* o = C.out + O_Y + (size_t)m * D + c; const f32x4 x1 = *(const f32x4*)o;
            *(f32x4*)o = x1 + gt * ((y[j] * r) * g); }
    }
}
__device__ __forceinline__ void p4_cumsum(const Ctx& C) {
    const int gw = C.vcu * NWAVES + C.wave, NGW = C.G * NWAVES, lane = C.lane;
    const float* LFA = (const float*)(C.ws + WS_LFA); float* GN = (float*)(C.ws + WS_GN);
    for (int bh = gw; bh < NB * AH; bh += NGW) {
        const int b = bh >> 3, h = bh & 7; const float* src = LFA + ((size_t)b * SEQ + 64 * lane) * AH + h;
        float tot = 0.f;
        for (int i = 0; i < 64; ++i) tot += src[(size_t)i * AH];
        const float incl = wave_scan_add(tot, lane); float run = incl - tot;
        float* dst = GN + (size_t)bh * SEQ + 64 * lane;
        for (int i = 0; i < 64; ++i) { run += src[(size_t)i * AH]; dst[i] = -LOG2E * run; }
    }
}

constexpr int KTP = 72;
constexpr int QTP = 136;
__device__ __forceinline__ void conv8(const Ctx& C, const bf16* QKB, size_t row, int tloc, int cc, const float* prev  , float (&y)[8]) {
    const f32x4 b0 = *(const f32x4*)(C.conv_b + cc), b1 = *(const f32x4*)(C.conv_b + cc + 4);
    y[0] = b0.x; y[1] = b0.y; y[2] = b0.z; y[3] = b0.w; y[4] = b1.x; y[5] = b1.y; y[6] = b1.z; y[7] = b1.w;
#pragma unroll
    for (int j = 0; j < 4; ++j) {
        const int tt = tloc - 3 + j; float x[8];
        if (tt >= 0) { const u16x8 xv = *(const u16x8*)(QKB + (row - 3 + j) * 1024 + cc);
#pragma unroll
            for (int e = 0; e < 8; ++e) x[e] = bf2f(xv[e]); }
        else if (prev) { const f32x4 p0 = *(const f32x4*)(prev + (size_t)(3 + tt) * 1024 + cc), p1 = *(const f32x4*)(prev + (size_t)(3 + tt) * 1024 + cc + 4);
            x[0] = p0.x; x[1] = p0.y; x[2] = p0.z; x[3] = p0.w; x[4] = p1.x; x[5] = p1.y; x[6] = p1.z; x[7] = p1.w; }
        else {
#pragma unroll
            for (int e = 0; e < 8; ++e) x[e] = 0.f; }
        const f32x4 w0 = *(const f32x4*)(C.conv_w + j * 1024 + cc), w1 = *(const f32x4*)(C.conv_w + j * 1024 + cc + 4);
        y[0] += w0.x * x[0]; y[1] += w0.y * x[1]; y[2] += w0.z * x[2]; y[3] += w0.w * x[3]; y[4] += w1.x * x[4]; y[5] += w1.y * x[5]; y[6] += w1.z * x[6]; y[7] += w1.w * x[7];
    }
#pragma unroll
    for (int e = 0; e < 8; ++e) y[e] = siluf(y[e]);
}

__device__ __forceinline__ void p4_mlstm_a(const Ctx& C) {
    const int tid = C.tid, lane = C.lane, wave = C.wave;
    const bf16* QKB = (const bf16*)(C.ws + WS_QKB); const bf16* VB = (const bf16*)(C.ws + WS_VB); bf16* MQ = (bf16*)(C.ws + WS_MQ); bf16* MK = (bf16*)(C.ws + WS_MK);
    const float* IPRE = (const float*)(C.ws + WS_IPRE); const float* LFB = (const float*)(C.ws + WS_LFB);
    float* KVT = (float*)(C.ws + WS_KVT); float* KN = (float*)(C.ws + WS_KN); float* BLML = (float*)(C.ws + WS_BLML);
    LAS bf16* KT = (LAS bf16*)(C.lds); LAS bf16* VT = (LAS bf16*)(C.lds + 18432); LAS float* sw = (LAS float*)(C.lds + 36864);
    for (int u = C.vcu; u < NB * BHN * 64; u += C.G) {
        const int bh = u >> 6, c = u & 63, b = bh >> 2, h = bh & 3; const size_t R0 = (size_t)b * SEQ + 64 * c;
        if (wave == 0) {
            const float ip = IPRE[(R0 + lane) * 4 + h], lf = LFB[(R0 + lane) * 4 + h];
            const float bc = wave_scan_add(lf, lane), bl = __shfl(bc, 63), wl = bl - bc + ip, ml = wave_max(wl);
            sw[lane] = __expf(wl - ml);
            if (lane == 0) { BLML[2 * u] = bl; BLML[2 * u + 1] = ml; }
        }
        __syncthreads();
#pragma unroll 1
        for (int i = 0; i < 4; ++i) { const int item = tid + 512 * i, tensor = item >> 10, t = (item >> 4) & 63, cg = item & 15, cc = tensor * 512 + h * 128 + cg * 8;
            float y[8]; conv8(C, QKB, R0 + t, 64 * c + t, cc, nullptr, y);
            if (tensor == 1) {
#pragma unroll
                for (int e = 0; e < 8; ++e) y[e] *= 0.08838834764831845f; }
            v4u o; o.x = pk2(y[0], y[1]); o.y = pk2(y[2], y[3]); o.z = pk2(y[4], y[5]); o.w = pk2(y[6], y[7]);
            *(v4u*)((tensor ? MK : MQ) + (R0 + t) * 512 + h * 128 + cg * 8) = o;
            if (tensor == 1) { const float w = sw[t];
#pragma unroll
                for (int e = 0; e < 8; ++e) KT[(cg * 8 + e) * KTP + t] = (bf16)f2bf(w * y[e]); }
        }
#pragma unroll
        for (int i = 0; i < 2; ++i) { const int item = tid + 512 * i, t = item >> 4, cg = item & 15;
            const u16x8 xv = *(const u16x8*)(VB + (R0 + t) * 512 + h * 128 + cg * 8);
#pragma unroll
            for (int e = 0; e < 8; ++e) VT[(cg * 8 + e) * KTP + t] = xv[e]; }
        __syncthreads();
        {
            const int fr = lane & 15, fq = lane >> 4;
            bf16x8 bfr[2];
#pragma unroll
            for (int ks = 0; ks < 2; ++ks) bfr[ks] = *(const LAS bf16x8*)(VT + (16 * wave + fr) * KTP + 32 * ks + 8 * fq);
            float* dst = KVT + (size_t)u * 16384 + (size_t)(16 * wave + fr) * 128 + 4 * fq;
#pragma unroll
            for (int dt = 0; dt < 8; ++dt) { f32x4 acc = (f32x4){0.f, 0.f, 0.f, 0.f};
#pragma unroll
                for (int ks = 0; ks < 2; ++ks) { const bf16x8 a = *(const LAS bf16x8*)(KT + (16 * dt + fr) * KTP + 32 * ks + 8 * fq); acc = MFMA16(a, bfr[ks], acc); }
                *(f32x4*)(dst + 16 * dt) = acc; }
        }
        if (tid < 128) { float s = 0.f;
#pragma unroll
            for (int k8 = 0; k8 < 8; ++k8) { const u16x8 xv = *(const LAS u16x8*)(KT + tid * KTP + 8 * k8);
#pragma unroll
                for (int e = 0; e < 8; ++e) s += bf2f(xv[e]); }
            KN[(size_t)u * 128 + tid] = s; }
        __syncthreads();
    }
}

__device__ __forceinline__ void p5_mlstm_b(const Ctx& C) {
    const float* KVT = (const float*)(C.ws + WS_KVT); const float* KN = (const float*)(C.ws + WS_KN); const float* BLML = (const float*)(C.ws + WS_BLML);
    bf16* CST = (bf16*)(C.ws + WS_CST); float* NST = (float*)(C.ws + WS_NST); float* MST = (float*)(C.ws + WS_MST);
    const int NT_ = C.G * NWAVES * 64;
    for (int idx = C.vcu * (NWAVES * 64) + C.tid; idx < 16 * 16384; idx += NT_) {
        const int bh = idx >> 14, rem = idx & 16383;
        float m = 0.f, cs = 0.f; const float* kv = KVT + (size_t)bh * 64 * 16384 + rem; bf16* cst = CST + (size_t)bh * 64 * 16384 + rem; const float* blml = BLML + bh * 128;
#pragma unroll 1
        for (int c0 = 0; c0 < 64; c0 += 8) { float kvv[8];
#pragma unroll
            for (int i = 0; i < 8; ++i) kvv[i] = kv[(size_t)(c0 + i) * 16384];
#pragma unroll
            for (int i = 0; i < 8; ++i) { const float bl = blml[2 * (c0 + i)], ml = blml[2 * (c0 + i) + 1];
                cst[(size_t)(c0 + i) * 16384] = (bf16)f2bf(cs);
                const float mn = fmaxf(bl + m, ml); cs = __expf(bl + m - mn) * cs + __expf(ml - mn) * kvv[i]; m = mn; } }
        C.out[O_CP + (size_t)bh * 16384 + (rem & 127) * 128 + (rem >> 7)] = cs;
    }
    for (int idx = C.vcu * (NWAVES * 64) + C.tid; idx < 16 * 128; idx += NT_) {
        const int bh = idx >> 7, d = idx & 127; float m = 0.f, ns = 0.f; const float* blml = BLML + bh * 128;
#pragma unroll 1
        for (int c = 0; c < 64; ++c) { const float bl = blml[2 * c], ml = blml[2 * c + 1], kn = KN[(size_t)(bh * 64 + c) * 128 + d];
            NST[(size_t)(bh * 64 + c) * 128 + d] = ns; if (d == 0) MST[bh * 64 + c] = m;
            const float mn = fmaxf(bl + m, ml); ns = __expf(bl + m - mn) * ns + __expf(ml - mn) * kn; m = mn; }
        C.out[O_NP + bh * 128 + d] = ns; if (d == 0) C.out[O_MP + bh] = m;
    }
}

__device__ __forceinline__ void p6_mlstm_c(const Ctx& C) {
    const int tid = C.tid, lane = C.lane, wave = C.wave, fr = lane & 15, fq = lane >> 4;
    const bf16* MQ = (const bf16*)(C.ws + WS_MQ); const bf16* MK = (const bf16*)(C.ws + WS_MK); const bf16* VB = (const bf16*)(C.ws + WS_VB); const bf16* SBO = (const bf16*)(C.ws + WS_SBO);
    const float* IPRE = (const float*)(C.ws + WS_IPRE); const float* LFB = (const float*)(C.ws + WS_LFB);
    const bf16* CST = (const bf16*)(C.ws + WS_CST); const float* NST = (const float*)(C.ws + WS_NST); const float* MST = (const float*)(C.ws + WS_MST); bf16* HB = (bf16*)(C.ws + WS_HB);
    LAS bf16* QT = (LAS bf16*)(C.lds); LAS bf16* KT2 = (LAS bf16*)(C.lds + 17408); LAS bf16* VT = (LAS bf16*)(C.lds + 34816); LAS bf16* AT = (LAS bf16*)(C.lds + 53248);
    LAS float* fb = (LAS float*)(C.lds + 62464); LAS float* bcs = fb; LAS float* us = fb + 64; LAS float* gts = fb + 128; LAS float* sis = fb + 192; LAS float* inv = fb + 256; LAS float* nsl = fb + 320;
    for (int u = C.vcu; u < NB * BHN * 64; u += C.G) {
        const int bh = u >> 6, c = u & 63, b = bh >> 2, h = bh & 3; const size_t R0 = (size_t)b * SEQ + 64 * c;
        const float mc = MST[u];
#pragma unroll
        for (int i = 0; i < 2; ++i) { const int item = tid + 512 * i, t = item >> 4, cg = item & 15; const size_t g = (R0 + t) * 512 + h * 128 + cg * 8;
            *(LAS v4u*)(QT + t * QTP + cg * 8) = *(const v4u*)(MQ + g); *(LAS v4u*)(KT2 + t * QTP + cg * 8) = *(const v4u*)(MK + g);
            const u16x8 xv = *(const u16x8*)(VB + g);
#pragma unroll
            for (int e = 0; e < 8; ++e) VT[(cg * 8 + e) * KTP + t] = xv[e]; }
        if (wave == 0) {
            const float ip = IPRE[(R0 + lane) * 4 + h], lf = LFB[(R0 + lane) * 4 + h];
            const float bc = wave_scan_add(lf, lane), uu = ip - bc, pm = wave_scan_max(uu, lane), g = fmaxf(mc, pm);
            bcs[lane] = bc; us[lane] = uu; gts[lane] = g; sis[lane] = __expf(mc - g);
        }
        if (wave == 1) { nsl[lane] = NST[(size_t)u * 128 + lane]; nsl[64 + lane] = NST[(size_t)u * 128 + 64 + lane]; }
        __syncthreads();
        {
            const int st = wave & 3;
#pragma unroll
            for (int q = 0; q < 2; ++q) { const int tt = 2 * (wave >> 2) + q; f32x4 acc = (f32x4){0.f, 0.f, 0.f, 0.f};
                if (st <= tt) {
#pragma unroll
                    for (int ks = 0; ks < 4; ++ks) { const bf16x8 a = *(const LAS bf16x8*)(KT2 + (16 * st + fr) * QTP + 32 * ks + 8 * fq), bb = *(const LAS bf16x8*)(QT + (16 * tt + fr) * QTP + 32 * ks + 8 * fq);
                        acc = MFMA16(a, bb, acc); } }
                const int t = 16 * tt + fr, s0 = 16 * st + 4 * fq; const float g = gts[t]; float av[4];
#pragma unroll
                for (int e = 0; e < 4; ++e) av[e] = (s0 + e <= t) ? __expf(us[s0 + e] - g) * acc[e] : 0.f;
                u32x2 o; o.x = pk2(av[0], av[1]); o.y = pk2(av[2], av[3]); *(LAS u32x2*)(AT + t * KTP + s0) = o; }
        }
        __syncthreads();
        if (tid < 64) {
            const int t = tid; float rs = 0.f, qn = 0.f;
#pragma unroll
            for (int k8 = 0; k8 < 8; ++k8) { const u16x8 xv = *(const LAS u16x8*)(AT + t * KTP + 8 * k8);
#pragma unroll
                for (int e = 0; e < 8; ++e) rs += bf2f(xv[e]); }
#pragma unroll
            for (int k8 = 0; k8 < 16; ++k8) { const u16x8 xv = *(const LAS u16x8*)(QT + t * QTP + 8 * k8);
#pragma unroll
                for (int e = 0; e < 8; ++e) qn += bf2f(xv[e]) * nsl[8 * k8 + e]; }
            const float den = rs + sis[t] * qn, mt = bcs[t] + gts[t];
            inv[t] = 1.0f / fmaxf(fabsf(den), __expf(-mt));
        }
        {
            bf16x8 av[2], ac[4];
#pragma unroll
            for (int ks = 0; ks < 2; ++ks) av[ks] = *(const LAS bf16x8*)(VT + (16 * wave + fr) * KTP + 32 * ks + 8 * fq);
#pragma unroll
            for (int ks = 0; ks < 4; ++ks) ac[ks] = *(const bf16x8*)(CST + (size_t)u * 16384 + (size_t)(16 * wave + fr) * 128 + 32 * ks + 8 * fq);
            f32x4 a1[4], a2[4];
#pragma unroll
            for (int tt = 0; tt < 4; ++tt) { a1[tt] = (f32x4){0.f, 0.f, 0.f, 0.f}; a2[tt] = (f32x4){0.f, 0.f, 0.f, 0.f};
#pragma unroll
                for (int ks = 0; ks < 2; ++ks) { const bf16x8 bb = *(const LAS bf16x8*)(AT + (16 * tt + fr) * KTP + 32 * ks + 8 * fq); a1[tt] = MFMA16(av[ks], bb, a1[tt]); }
#pragma unroll
                for (int ks = 0; ks < 4; ++ks) { const bf16x8 bb = *(const LAS bf16x8*)(QT + (16 * tt + fr) * QTP + 32 * ks + 8 * fq); a2[tt] = MFMA16(ac[ks], bb, a2[tt]); } }
            __syncthreads();
#pragma unroll
            for (int tt = 0; tt < 4; ++tt) { const int t = 16 * tt + fr; const float si = sis[t], iv = inv[t]; const size_t g = (R0 + t) * 512 + h * 128 + 16 * wave + 4 * fq;
                const u16x4 sb = *(const u16x4*)(SBO + g); float hv[4];
#pragma unroll
                for (int e = 0; e < 4; ++e) hv[e] = (a1[tt][e] + si * a2[tt][e]) * iv * bf2f(sb[e]);
                u32x2 o; o.x = pk2(hv[0], hv[1]); o.y = pk2(hv[2], hv[3]); *(u32x2*)(HB + g) = o; }
        }
        __syncthreads();
    }
}
__device__ __forceinline__ void p4_mlstm_sample(const Ctx& C) {
    const int tid = C.tid;
    const bf16* QKB = (const bf16*)(C.ws + WS_QKB); const bf16* VB = (const bf16*)(C.ws + WS_VB); const bf16* SBO = (const bf16*)(C.ws + WS_SBO); bf16* HB = (bf16*)(C.ws + WS_HB);
    const float* IPRE = (const float*)(C.ws + WS_IPRE); const float* LFB = (const float*)(C.ws + WS_LFB);
    LAS float* sq = (LAS float*)(C.lds + 65536); LAS float* sk = sq + 512; LAS float* sv = sk + 512; LAS float* wk = sv + 512; LAS float* red = wk + 512;
    LAS float* sm = red + 2048;
    for (int u = C.vcu; u < DB * BHN; u += C.G) {
        const int b = u >> 2, h = u & 3; const size_t R0 = (size_t)MP + 4 * b; const size_t sbase = (size_t)u * 128;
        if (tid < 128) { const int tensor = tid >> 6, t = (tid >> 4) & 3, cg = tid & 15, cc = tensor * 512 + h * 128 + cg * 8; float y[8];
            conv8(C, QKB, R0 + t, t, cc, C.state_conv + (size_t)b * 3 * 1024, y);
#pragma unroll
            for (int e = 0; e < 8; ++e) (tensor ? sk : sq)[t * 128 + cg * 8 + e] = tensor ? y[e] * 0.08838834764831845f : y[e]; }
        { const int t = tid >> 7, e = tid & 127; sv[t * 128 + e] = bf2f(VB[(R0 + t) * 512 + h * 128 + e]); }
        if (tid == 0) { const float m0 = C.state_m[u]; float bc = 0.f, pm = -INFINITY, uu[4], g[4];
#pragma unroll
            for (int t = 0; t < 4; ++t) { bc += LFB[(R0 + t) * 4 + h]; uu[t] = IPRE[(R0 + t) * 4 + h] - bc; pm = fmaxf(pm, uu[t]); g[t] = fmaxf(m0, pm);
                sm[t] = uu[t]; sm[4 + t] = g[t]; sm[8 + t] = __expf(m0 - g[t]); sm[12 + t] = bc + g[t]; }
#pragma unroll
            for (int s = 0; s < 4; ++s) sm[36 + s] = __expf(uu[s] - g[3]); }
        __syncthreads();
        if (tid < 16) { const int t = tid >> 2, s = tid & 3; float d = 0.f;
            for (int k = 0; k < 128; ++k) d += sq[t * 128 + k] * sk[s * 128 + k];
            sm[16 + tid] = (s <= t) ? __expf(sm[s] - sm[4 + t]) * d : 0.f; }
        else if (tid >= 64 && tid < 68) { const int t = tid - 64; float d = 0.f;
            for (int k = 0; k < 128; ++k) d += sq[t * 128 + k] * C.state_n[sbase + k];
            sm[32 + t] = d; }
        { const int s = tid >> 7, d = tid & 127; wk[s * 128 + d] = sm[36 + s] * sk[s * 128 + d]; }
        __syncthreads();
        {
            const int e = tid & 127, dq = tid >> 7; const float decay = sm[8 + 3]; float p0 = 0.f, p1 = 0.f, p2 = 0.f, p3 = 0.f;
            const float v0 = sv[e], v1 = sv[128 + e], v2 = sv[256 + e], v3 = sv[384 + e];
            const float* c0p = C.state_C + (sbase + 32 * dq) * 128 + e; float* cnp = C.out + O_CS + (sbase + 32 * dq) * 128 + e;
#pragma unroll 8
            for (int dd = 0; dd < 32; ++dd) { const int d = 32 * dq + dd; const float c0 = c0p[(size_t)dd * 128];
                p0 += sq[d] * c0; p1 += sq[128 + d] * c0; p2 += sq[256 + d] * c0; p3 += sq[384 + d] * c0;
                cnp[(size_t)dd * 128] = decay * c0 + (wk[d] * v0 + wk[128 + d] * v1) + (wk[256 + d] * v2 + wk[384 + d] * v3); }
            red[(dq * 4 + 0) * 128 + e] = p0; red[(dq * 4 + 1) * 128 + e] = p1; red[(dq * 4 + 2) * 128 + e] = p2; red[(dq * 4 + 3) * 128 + e] = p3;
        }
        __syncthreads();
        { const int t = tid >> 7, e = tid & 127; float num = 0.f, den = 0.f;
#pragma unroll
            for (int s = 0; s < 4; ++s) { const float a = sm[16 + t * 4 + s]; num += a * sv[s * 128 + e]; den += a; }
            const float si = sm[8 + t]; num += si * ((red[(0 * 4 + t) * 128 + e] + red[(1 * 4 + t) * 128 + e]) + (red[(2 * 4 + t) * 128 + e] + red[(3 * 4 + t) * 128 + e]));
            den += si * sm[32 + t];
            const float hv = num / fmaxf(fabsf(den), __expf(-sm[12 + t]));
            const size_t g = (R0 + t) * 512 + h * 128 + e; HB[g] = (bf16)f2bf(hv * bf2f(SBO[g])); }
        if (tid < 128) { const int d = tid; C.out[O_NS + sbase + d] = sm[8 + 3] * C.state_n[sbase + d] + (wk[d] + wk[128 + d]) + (wk[256 + d] + wk[384 + d]); }
        if (tid == 0) C.out[O_MS + u] = sm[12 + 3];
        __syncthreads();
    }
}

constexpr float SKIP_THRESH = 64.0f;
__device__ __forceinline__ void p4_norms(const Ctx& C) {
    const int gw = C.vcu * NWAVES + C.wave, NGW = C.G * NWAVES, lane = C.lane;
    const bf16* QA = (const bf16*)(C.ws + WS_QA); const bf16* KA = (const bf16*)(C.ws + WS_KA); float* QN2 = (float*)(C.ws + WS_QN2); float* KN2 = (float*)(C.ws + WS_KN2);
    for (int m = gw; m < MP; m += NGW) {
        const u16x8 qv = *(const u16x8*)(QA + (size_t)m * 512 + 8 * lane), kv = *(const u16x8*)(KA + (size_t)m * 512 + 8 * lane); float sq = 0.f, sk = 0.f;
#pragma unroll
        for (int e = 0; e < 8; ++e) { const float a = bf2f(qv[e]), b = bf2f(kv[e]); sq += a * a; sk += b * b; }
        sq += __shfl_xor(sq, 1); sq += __shfl_xor(sq, 2); sq += __shfl_xor(sq, 4); sk += __shfl_xor(sk, 1); sk += __shfl_xor(sk, 2); sk += __shfl_xor(sk, 4);
        if ((lane & 7) == 0) { QN2[(size_t)m * 8 + (lane >> 3)] = sqrtf(sq) * 1.0001f; KN2[(size_t)m * 8 + (lane >> 3)] = sqrtf(sk) * 1.0001f; }
    }
}
__device__ __forceinline__ void p5_attn_t0(const Ctx& C) {
    const int gw = C.vcu * NWAVES + C.wave, NGW = C.G * NWAVES, lane = C.lane;
    const float* QN2 = (const float*)(C.ws + WS_QN2); const float* KN2 = (const float*)(C.ws + WS_KN2); const float* GN = (const float*)(C.ws + WS_GN); int* T0 = (int*)(C.ws + WS_T0);
    for (int bh = gw; bh < NB * AH; bh += NGW) {
        const int b = bh >> 3, h = bh & 7; const size_t r0 = (size_t)b * SEQ + 64 * lane;
        float km = 0.f, qm = 0.f;
        for (int i = 0; i < 64; ++i) { km = fmaxf(km, KN2[(r0 + i) * 8 + h]); qm = fmaxf(qm, QN2[(r0 + i) * 8 + h]); }
        float kg = fmaxf(km, __shfl_xor(km, 1)); kg = fmaxf(kg, __shfl_xor(kg, 2));
        float qg = fmaxf(qm, __shfl_xor(qm, 1)); qg = fmaxf(qg, __shfl_xor(qg, 2));
        const float glast = GN[(size_t)bh * SEQ + 64 * lane + 63];
        for (int qb = 0; qb < SEQ / 256; ++qb) {
            const int NT = 4 * qb + 4; const float qmax = __shfl(qg, 4 * qb), kq = __shfl(kg, 4 * qb), g0 = GN[(size_t)bh * SEQ + 256 * qb];
            const float B = qmax * (km + kq) + glast - g0;
            const bool skippable = (lane < NT - 4) && (B < -SKIP_THRESH);
            const unsigned long long keep = __ballot(!skippable);
            int t0 = (int)__builtin_ctzll(keep); t0 &= ~1; if (t0 > NT - 4) t0 = NT - 4;
            if (lane == 0) T0[bh * (SEQ / 256) + qb] = t0;
        }
    }
}

__device__ __forceinline__ float red16(float v) {
    v += __shfl_xor(v, 1); v += __shfl_xor(v, 2); v += __shfl_xor(v, 4); v += __shfl_xor(v, 8); return v;
}
__device__ __forceinline__ void p4_decode1a(const Ctx& C) {
    const int lane = C.lane, h = C.wave, l15 = lane & 15, grp = lane >> 4;
    const bf16* QA = (const bf16*)(C.ws + WS_QA); float* SCR = (float*)(C.ws + WS_SCR); float* PM = (float*)(C.ws + WS_PM);
    LAS float* gl = (LAS float*)(C.lds + 98304) + h * 640; LAS float* sc = gl + 128;
    for (int it = C.vcu; it < DB * NPAGES; it += C.G) {
        const int b = it & 127, p = it >> 7; const int phys = C.page_table[b * NPAGES + p];
        const float* kb = C.cache_k + ((size_t)phys * PAGE * AH + h) * 64 + 4 * l15;
        const float lf0 = C.cache_logf[((size_t)phys * PAGE + lane) * AH + h] * LOG2E, lf1 = C.cache_logf[((size_t)phys * PAGE + 64 + lane) * AH + h] * LOG2E;
        const float s0 = wave_scan_add(lf0, lane), t0 = __shfl(s0, 63), s1 = wave_scan_add(lf1, lane) + t0, T = __shfl(s1, 63);
        gl[lane] = s0; gl[64 + lane] = s1;
        f32x4 q[4];
#pragma unroll
        for (int j = 0; j < 4; ++j) { const u16x4 qv = *(const u16x4*)(QA + ((size_t)MP + 4 * b + j) * 512 + h * 64 + 4 * l15); q[j] = (f32x4){bf2f(qv[0]), bf2f(qv[1]), bf2f(qv[2]), bf2f(qv[3])}; }
#pragma unroll 1
        for (int i0 = 0; i0 < 32; i0 += 8) { f32x4 kv[8];
#pragma unroll
            for (int i = 0; i < 8; ++i) kv[i] = __builtin_nontemporal_load((const f32x4*)(kb + (size_t)(4 * (i0 + i) + grp) * (AH * 64)));
#pragma unroll
            for (int i = 0; i < 8; ++i) { const int tk = 4 * (i0 + i) + grp; float d[4];
#pragma unroll
                for (int j = 0; j < 4; ++j) d[j] = red16((kv[i].x * q[j].x + kv[i].y * q[j].y) + (kv[i].z * q[j].z + kv[i].w * q[j].w));
                if (l15 == 0) { const float g = gl[tk]; *(LAS f32x4*)(sc + 4 * tk) = (f32x4){d[0] - g, d[1] - g, d[2] - g, d[3] - g}; } } }
        const f32x4 sa = *(const LAS f32x4*)(sc + 4 * lane), sb = *(const LAS f32x4*)(sc + 4 * (64 + lane));
        float* dsc = SCR + ((size_t)((b * NPAGES + p) * AH + h)) * 512; *(f32x4*)(dsc + 4 * lane) = sa; *(f32x4*)(dsc + 4 * (64 + lane)) = sb;
        float mj[4];
#pragma unroll
        for (int j = 0; j < 4; ++j) mj[j] = wave_max(fmaxf(sa[j], sb[j]));
        if (lane == 0) { float* pm = PM + ((size_t)((b * NPAGES + p) * AH + h)) * 8; *(f32x4*)pm = (f32x4){mj[0], mj[1], mj[2], mj[3]}; pm[4] = T; }
    }
}
__device__ __forceinline__ void p5_decode1b(const Ctx& C) {
    const int lane = C.lane, h = C.wave, l15 = lane & 15, grp = lane >> 4;
    const float* SCR = (const float*)(C.ws + WS_SCR); const float* PM = (const float*)(C.ws + WS_PM); float* PART = (float*)(C.ws + WS_PART);
    LAS float* sc = (LAS float*)(C.lds + 98304) + h * 640 + 128;
    for (int it = C.vcu; it < DB * NPAGES; it += C.G) {
        const int b = it & 127, p = it >> 7;
        const float* pm = PM + ((size_t)((b * NPAGES + l15) * AH + h)) * 8; const f32x4 mp = *(const f32x4*)pm; const float Tp = pm[4];
        float pre = Tp;
#pragma unroll
        for (int o = 1; o < 16; o <<= 1) { const float t = __shfl_up(pre, o, 16); if (l15 >= o) pre += t; }
        pre -= Tp;
        float Mx[4], mine[4]; const float mypre = __shfl(pre, p, 16); bool keep = false;
#pragma unroll
        for (int j = 0; j < 4; ++j) { float v = mp[j] - pre; const float own = __shfl(v, p, 16);
            v = fmaxf(v, __shfl_xor(v, 1)); v = fmaxf(v, __shfl_xor(v, 2)); v = fmaxf(v, __shfl_xor(v, 4)); v = fmaxf(v, __shfl_xor(v, 8)); Mx[j] = v; mine[j] = own; keep = keep || (own - v >= -SKIP_THRESH); }
        float* dst = PART + ((size_t)((b * NPAGES + p) * AH + h) * 4) * PART_STRIDE;
        if (!keep) { if (lane == 0) {
#pragma unroll
                for (int j = 0; j < 4; ++j) { dst[j * PART_STRIDE + 64] = Mx[j]; dst[j * PART_STRIDE + 65] = 0.f; dst[j * PART_STRIDE + 66] = 0.f; } }
            continue; }
        const int phys = C.page_table[b * NPAGES + p];
        const float* vb = C.cache_v + ((size_t)phys * PAGE * AH + h) * 64 + 4 * l15;
        const float* ssc = SCR + ((size_t)((b * NPAGES + p) * AH + h)) * 512;
        f32x4 sa = *(const f32x4*)(ssc + 4 * lane), sb = *(const f32x4*)(ssc + 4 * (64 + lane)); float lj[4];
#pragma unroll
        for (int j = 0; j < 4; ++j) { sa[j] = __builtin_amdgcn_exp2f(sa[j] - mypre - Mx[j]); sb[j] = __builtin_amdgcn_exp2f(sb[j] - mypre - Mx[j]); lj[j] = wave_sum(sa[j] + sb[j]); }
        *(LAS f32x4*)(sc + 4 * lane) = sa; *(LAS f32x4*)(sc + 4 * (64 + lane)) = sb;
        f32x4 acc[4];
#pragma unroll
        for (int j = 0; j < 4; ++j) acc[j] = (f32x4){0.f, 0.f, 0.f, 0.f};
#pragma unroll 1
        for (int i0 = 0; i0 < 32; i0 += 8) { f32x4 vv[8];
#pragma unroll
            for (int i = 0; i < 8; ++i) vv[i] = __builtin_nontemporal_load((const f32x4*)(vb + (size_t)(4 * (i0 + i) + grp) * (AH * 64)));
#pragma unroll
            for (int i = 0; i < 8; ++i) { const f32x4 pj = *(const LAS f32x4*)(sc + 4 * (4 * (i0 + i) + grp));
#pragma unroll
                for (int j = 0; j < 4; ++j) acc[j] += vv[i] * pj[j]; } }
#pragma unroll
        for (int j = 0; j < 4; ++j)
#pragma unroll
            for (int e = 0; e < 4; ++e) { float a = acc[j][e]; a += __shfl_xor(a, 16); a += __shfl_xor(a, 32); acc[j][e] = a; }
        if (grp == 0) {
#pragma unroll
            for (int j = 0; j < 4; ++j) *(f32x4*)(dst + j * PART_STRIDE + 4 * l15) = acc[j]; }
        if (lane == 0) {
#pragma unroll
            for (int j = 0; j < 4; ++j) { dst[j * PART_STRIDE + 64] = Mx[j]; dst[j * PART_STRIDE + 65] = lj[j]; dst[j * PART_STRIDE + 66] = 1.0f; } }
    }
}
__device__ __forceinline__ void p6_decode2(const Ctx& C) {
    const int tid = C.tid, h = tid >> 6, j = (tid >> 4) & 3, ch = tid & 15;
    const bf16* QA = (const bf16*)(C.ws + WS_QA); const bf16* KA = (const bf16*)(C.ws + WS_KA); const bf16* VA = (const bf16*)(C.ws + WS_VA); bf16* OA = (bf16*)(C.ws + WS_OA);
    const float* LFA = (const float*)(C.ws + WS_LFA); const float* PART = (const float*)(C.ws + WS_PART); const float* PM = (const float*)(C.ws + WS_PM);
    for (int b = C.vcu; b < DB; b += C.G) {
        const size_t R0 = (size_t)MP + 4 * b;
        float L = 0.f, pre = 0.f; f32x4 acc = (f32x4){0.f, 0.f, 0.f, 0.f};
        const float Mref = PART[((size_t)((b * NPAGES + 0) * AH + h) * 4 + j) * PART_STRIDE + 64];
#pragma unroll 4
        for (int p = 0; p < NPAGES; ++p) { const float* src = PART + ((size_t)((b * NPAGES + p) * AH + h) * 4 + j) * PART_STRIDE;
            pre += PM[((size_t)((b * NPAGES + p) * AH + h)) * 8 + 4];
            if (src[66] != 0.f) { L += src[65]; acc += *(const f32x4*)(src + 4 * ch); } }
        const u16x4 qv = *(const u16x4*)(QA + (R0 + j) * 512 + h * 64 + 4 * ch); float sn[4]; float g2 = pre, Mx = Mref;
#pragma unroll
        for (int i = 0; i < 4; ++i) { const u16x4 kv = *(const u16x4*)(KA + (R0 + i) * 512 + h * 64 + 4 * ch);
            const float d = red16((bf2f(qv[0]) * bf2f(kv[0]) + bf2f(qv[1]) * bf2f(kv[1])) + (bf2f(qv[2]) * bf2f(kv[2]) + bf2f(qv[3]) * bf2f(kv[3])));
            g2 += LFA[(R0 + i) * AH + h] * LOG2E; sn[i] = (i <= j) ? d - g2 : -INFINITY; Mx = fmaxf(Mx, sn[i]); }
        const float sc0 = __builtin_amdgcn_exp2f(Mref - Mx); L *= sc0; acc = acc * sc0;
#pragma unroll
        for (int i = 0; i < 4; ++i) { const float w = __builtin_amdgcn_exp2f(sn[i] - Mx); const u16x4 vv = *(const u16x4*)(VA + (R0 + i) * 512 + h * 64 + 4 * ch);
            L += w; acc += (f32x4){bf2f(vv[0]), bf2f(vv[1]), bf2f(vv[2]), bf2f(vv[3])} * w; }
        const float il = 1.0f / L; u32x2 o; o.x = pk2(acc.x * il, acc.y * il); o.y = pk2(acc.z * il, acc.w * il);
        *(u32x2*)(OA + (R0 + j) * 512 + h * 64 + 4 * ch) = o;
    }
}
template <int K, class Epi>
__device__ __forceinline__ void skinny_gemm(const Ctx& C, const bf16* A, const bf16* Bt, int N, const Epi& E) {
    constexpr int KW = K / 8, NS = KW / 32, CH = NS < 4 ? NS : 4;
    const int lane = C.lane, wave = C.wave, fr = lane & 15, fq = lane >> 4, tid = C.tid;
    LAS float* red = (LAS float*)(C.lds);
    const int total = 16 * (N / 64);
    for (int u = C.vcu; u < total; u += C.G) {
        const int cb = u >> 4, rb = u & 15;
        const bf16* ap = A + (size_t)(rb * 32 + fr) * K + wave * KW + 8 * fq;
        const bf16* bp = Bt + (size_t)(cb * 64 + fr) * K + wave * KW + 8 * fq;
        f32x4 acc[4][2];
#pragma unroll
        for (int ct = 0; ct < 4; ++ct) { acc[ct][0] = (f32x4){0.f, 0.f, 0.f, 0.f}; acc[ct][1] = (f32x4){0.f, 0.f, 0.f, 0.f}; }
#pragma unroll 1
        for (int s0 = 0; s0 < NS; s0 += CH) {
            bf16x8 wf[CH][4], af[CH][2];
#pragma unroll
            for (int ss = 0; ss < CH; ++ss) {
#pragma unroll
                for (int ct = 0; ct < 4; ++ct) wf[ss][ct] = *(const bf16x8*)(bp + (size_t)ct * 16 * K + (s0 + ss) * 32);
#pragma unroll
                for (int rt = 0; rt < 2; ++rt) af[ss][rt] = *(const bf16x8*)(ap + (size_t)rt * 16 * K + (s0 + ss) * 32); }
#pragma unroll
            for (int ss = 0; ss < CH; ++ss)
#pragma unroll
                for (int ct = 0; ct < 4; ++ct)
#pragma unroll
                    for (int rt = 0; rt < 2; ++rt) acc[ct][rt] = MFMA16(wf[ss][ct], af[ss][rt], acc[ct][rt]);
        }
#pragma unroll
        for (int ct = 0; ct < 4; ++ct)
#pragma unroll
            for (int rt = 0; rt < 2; ++rt) *(LAS f32x4*)(red + (wave * 32 + rt * 16 + fr) * 68 + ct * 16 + 4 * fq) = acc[ct][rt];
        __syncthreads();
        { const int m = tid >> 4, c4 = (tid & 15) * 4; f32x4 v = *(const LAS f32x4*)(red + m * 68 + c4);
#pragma unroll
            for (int w = 1; w < 8; ++w) v += *(const LAS f32x4*)(red + (w * 32 + m) * 68 + c4);
            E(rb * 32 + m, cb * 64 + c4, v); }
        __syncthreads();
    }
}
struct SkF32 { float* O; int ldc;
    __device__ __forceinline__ void operator()(int row, int col, f32x4 v) const { *(f32x4*)(O + (size_t)row * ldc + col) = v; } };
struct SkRelu2 { bf16* O; int ldc;
    __device__ __forceinline__ void operator()(int row, int col, f32x4 v) const { const float a = fmaxf(v.x, 0.f), b = fmaxf(v.y, 0.f), c = fmaxf(v.z, 0.f), d = fmaxf(v.w, 0.f);
        u32x2 o; o.x = pk2(a * a, b * b); o.y = pk2(c * c, d * d); *(u32x2*)(O + (size_t)row * ldc + col) = o; } };
struct SkGateA { float* T1; const bf16* SG; int ldc;
    __device__ __forceinline__ void operator()(int row, int col, f32x4 v) const { const size_t off = (size_t)row * ldc + col; const u16x4 g = *(const u16x4*)(SG + off);
        *(f32x4*)(T1 + off) = (f32x4){v.x * bf2f(g[0]), v.y * bf2f(g[1]), v.z * bf2f(g[2]), v.w * bf2f(g[3])}; } };
struct SkGateB { const float* T1; const bf16* SG; bf16* T; int ldc;
    __device__ __forceinline__ void operator()(int row, int col, f32x4 v) const { const size_t off = (size_t)row * ldc + col; const u16x4 g = *(const u16x4*)(SG + off); const f32x4 t = *(const f32x4*)(T1 + off);
        u32x2 o; o.x = pk2(t.x + v.x * bf2f(g[0]), t.y + v.y * bf2f(g[1])); o.y = pk2(t.z + v.z * bf2f(g[2]), t.w + v.w * bf2f(g[3])); *(u32x2*)(T + off) = o; } };
struct Args { const void* in[29]; float* out; unsigned char* ws; int ph_lo, ph_hi; };
static_assert(sizeof(Args) == 256, "Args has no padding bytes");
__global__ void __launch_bounds__(NWAVES * 64, 2) fox_fwd(Args args) {
    extern __shared__ __attribute__((aligned(16))) unsigned char lds[];
    Ctx C;
    C.lds = (LAS unsigned char*)lds;
    volatile LAS unsigned* MISC = (volatile LAS unsigned*)(C.lds + MISC_OFF);
    C.tid = threadIdx.x; C.lane = C.tid & 63; C.wave = __builtin_amdgcn_readfirstlane(C.tid >> 6);
    C.G = gridDim.x; { const int bx = blockIdx.x; C.vcu = (C.G % 8 == 0) ? (bx % 8) * (C.G / 8) + bx / 8 : bx; }
    C.ws = args.ws; C.out = args.out; C.ctl = (gu32*)(args.ws + WS_CTL);
    C.x_prompt = (const float*)args.in[0]; C.x_sample = (const float*)args.in[1]; C.cache_k = (const float*)args.in[2]; C.cache_v = (const float*)args.in[3]; C.cache_logf = (const float*)args.in[4];
    C.page_table = (const int*)args.in[5]; C.state_C = (const float*)args.in[6]; C.state_n = (const float*)args.in[7]; C.state_m = (const float*)args.in[8]; C.state_conv = (const float*)args.in[9];
    C.c_prompt = (const float*)args.in[10]; C.c_sample = (const float*)args.in[11]; C.w_ada = (const float*)args.in[12]; C.b_ada = (const float*)args.in[13];
    C.g_pre_mix = (const float*)args.in[14]; C.g_post_mix = (const float*)args.in[15]; C.g_pre_mlp = (const float*)args.in[16]; C.g_post_mlp = (const float*)args.in[17];
    C.w_in = (const float*)args.in[18]; C.b_fox_f = (const float*)args.in[19]; C.b_ml_i = (const float*)args.in[20]; C.b_ml_f = (const float*)args.in[21];
    C.conv_w = (const float*)args.in[22]; C.conv_b = (const float*)args.in[23]; C.w_proj_a = (const float*)args.in[24]; C.w_proj_b = (const float*)args.in[25];
    C.w_out = (const float*)args.in[26]; C.w_up = (const float*)args.in[27]; C.w_down = (const float*)args.in[28];
    unsigned char* ws = args.ws;
    for (int u = C.tid; u < (LDS_BYTES - LDSCTL_OFF) / 4; u += NWAVES * 64) ((LAS unsigned*)(C.lds + LDSCTL_OFF))[u] = 0u;
    __syncthreads();
    XcdBarrier bar; bar.bar = (unsigned*)(C.ctl + CW_BAR); bar.x = 0; bar.st = nullptr;
    if (ONE_LAUNCH) bar = xcd_barrier_post((unsigned*)(C.ctl + CW_BAR), MISC + 8);
#define GRID_BAR() do { if (ONE_LAUNCH) xcd_barrier(bar); } while (0)
    const int lo = args.ph_lo, hi = args.ph_hi;
#define IN(k) (lo <= (k) && (k) < hi)
#ifndef PROBE_MASK
#define PROBE_MASK 0
#endif
#define REP(k) for (int rep##k##_ = 0; rep##k##_ < (((PROBE_MASK) >> (k)) & 1) + 1; ++rep##k##_)
#define BOTH(k) (IN(k) && IN((k) + 1))
    typedef pg8::StaticOrder SO;
    if (IN(0)) { REP(0) p0_prologue(C); if (BOTH(0)) GRID_BAR(); }
    if (IN(1)) { pg8::Gemm g{(const bf16*)(ws + WS_SC), (const bf16*)(ws + WS_WADA), 256, NMODC, D}; SO S; S.init(256, NMODC, C.G, (int)blockIdx.x);
        pg8::EpiF32 E{(float*)(ws + WS_MOD), NMODC, C.b_ada};
        pg8::gemm_phase<pg8::EpiF32, SO, true, true>(C.lds + RING_OFF, g, S, E);
        if (BOTH(1)) GRID_BAR(); }
    if (IN(2)) { REP(2) p2_norm1(C); if (BOTH(2)) GRID_BAR(); }
    if (IN(3)) { pg8::Gemm g{(const bf16*)(ws + WS_XN), (const bf16*)(ws + WS_WIN), M, NINP, D}; SO S; S.init(M, NINP, C.G, (int)blockIdx.x);
        pg8::EpiIn E{(bf16*)(ws + WS_QA), (bf16*)(ws + WS_KA), (bf16*)(ws + WS_VA), (bf16*)(ws + WS_QKB), (bf16*)(ws + WS_VB), (bf16*)(ws + WS_SBO), (bf16*)(ws + WS_SGA), (bf16*)(ws + WS_SGB),
            (float*)(ws + WS_LFA), (float*)(ws + WS_IPRE), (float*)(ws + WS_LFB), C.out, C.b_fox_f, C.b_ml_i, C.b_ml_f, MP, O_KP, O_VP, O_LFP, O_CVP, O_KS, O_VS, O_LFS, O_CVS, attn_body::C2};
        pg8::gemm_phase<pg8::EpiIn, SO, true, true>(C.lds + RING_OFF, g, S, E);
        if (BOTH(3)) GRID_BAR(); }
    if (IN(4)) { REP(4) { REP(18) { p4_cumsum(C); p4_norms(C); } REP(19) { p4_mlstm_a(C); } REP(20) { p4_mlstm_sample(C); } REP(21) { p4_decode1a(C); } } if (BOTH(4)) GRID_BAR(); }
    if (IN(5)) { REP(5) { REP(22) { p5_mlstm_b(C); } REP(23) { p5_attn_t0(C); } REP(24) { p5_decode1b(C); } } if (BOTH(5)) GRID_BAR(); }
    if (IN(6)) {
        static_assert(attn_body::ATTN_LDS_BYTES <= RING_BYTES, "attention LDS");
        const attn_body::AttnTensors AT{(const attn_body::bf16*)(ws + WS_QA), (const attn_body::bf16*)(ws + WS_KA), (const attn_body::bf16*)(ws + WS_VA), (attn_body::bf16*)(ws + WS_OA), (const float*)(ws + WS_GN), (const int*)(ws + WS_T0)};
        const attn_body::StaticOrder S((int)C.G, C.vcu);
        attn_body::attn_phase<attn_body::StaticOrder>((char*)lds + RING_OFF, AT, S);
        __syncthreads();
#if (PROBE_MASK >> 6) & 1
        attn_body::attn_phase<attn_body::StaticOrder>((char*)lds + RING_OFF, AT, S);
        __syncthreads();
#endif
        REP(16) { p6_mlstm_c(C); } REP(17) { p6_decode2(C); }
        if (BOTH(6)) GRID_BAR(); }
    if (IN(7)) {
        { const size_t so = (size_t)MP * D;
          skinny_gemm<AW>(C, (const bf16*)(ws + WS_OA) + (size_t)MP * AW, (const bf16*)(ws + WS_WPA), D, SkGateA{(float*)(ws + WS_T1) + so, (const bf16*)(ws + WS_SGA) + so, D});
          VM_WAIT(); __syncthreads();
          skinny_gemm<BW>(C, (const bf16*)(ws + WS_HB) + (size_t)MP * BW, (const bf16*)(ws + WS_WPB), D, SkGateB{(const float*)(ws + WS_T1) + so, (const bf16*)(ws + WS_SGB) + so, (bf16*)(ws + WS_T) + so, D}); }
        { pg8::Gemm g{(const bf16*)(ws + WS_OA), (const bf16*)(ws + WS_WPA), MP, D, AW}; SO S; S.init(MP, D, C.G, (int)blockIdx.x);
          pg8::EpiGateA E{(float*)(ws + WS_T1), (const bf16*)(ws + WS_SGA), D};
          pg8::gemm_phase<pg8::EpiGateA, SO, true, true>(C.lds + RING_OFF, g, S, E); }
        VM_WAIT(); __syncthreads();
        { pg8::Gemm g{(const bf16*)(ws + WS_HB), (const bf16*)(ws + WS_WPB), MP, D, BW}; SO S; S.init(MP, D, C.G, (int)blockIdx.x);
          pg8::EpiGateB E{(const float*)(ws + WS_T1), (const bf16*)(ws + WS_SGB), (bf16*)(ws + WS_T), D};
          pg8::gemm_phase<pg8::EpiGateB, SO, true, true>(C.lds + RING_OFF, g, S, E); }
        if (BOTH(7)) GRID_BAR(); }
    if (IN(8)) { skinny_gemm<D>(C, (const bf16*)(ws + WS_T) + (size_t)MP * D, (const bf16*)(ws + WS_WOUT), D, SkF32{(float*)(ws + WS_Y) + (size_t)MP * D, D});
        pg8::Gemm g{(const bf16*)(ws + WS_T), (const bf16*)(ws + WS_WOUT), MP, D, D}; SO S; S.init(MP, D, C.G, (int)blockIdx.x);
        pg8::EpiF32 E{(float*)(ws + WS_Y), D, nullptr};
        pg8::gemm_phase<pg8::EpiF32, SO, true, true>(C.lds + RING_OFF, g, S, E);
        if (BOTH(8)) GRID_BAR(); }
    if (IN(9)) { REP(9) p9_norm2(C); if (BOTH(9)) GRID_BAR(); }
    if (IN(10)) { skinny_gemm<D>(C, (const bf16*)(ws + WS_XN) + (size_t)MP * D, (const bf16*)(ws + WS_WUP), FF, SkRelu2{(bf16*)(ws + WS_U) + (size_t)MP * FF, FF});
        pg8::Gemm g{(const bf16*)(ws + WS_XN), (const bf16*)(ws + WS_WUP), MP, FF, D}; SO S; S.init(MP, FF, C.G, (int)blockIdx.x);
        pg8::EpiRelu2 E{(bf16*)(ws + WS_U), FF};
        pg8::gemm_phase<pg8::EpiRelu2, SO, true, true>(C.lds + RING_OFF, g, S, E);
        if (BOTH(10)) GRID_BAR(); }
    if (IN(11)) { skinny_gemm<FF>(C, (const bf16*)(ws + WS_U) + (size_t)MP * FF, (const bf16*)(ws + WS_WDN), D, SkF32{(float*)(ws + WS_Y) + (size_t)MP * D, D});
        pg8::Gemm g{(const bf16*)(ws + WS_U), (const bf16*)(ws + WS_WDN), MP, D, FF}; SO S; S.init(MP, D, C.G, (int)blockIdx.x);
        pg8::EpiF32 E{(float*)(ws + WS_Y), D, nullptr};
        pg8::gemm_phase<pg8::EpiF32, SO, true, true>(C.lds + RING_OFF, g, S, E);
        if (BOTH(11)) GRID_BAR(); }
    if (IN(12)) { p12_final(C); }
#undef IN
#undef BOTH
}

extern "C" void kernel_launch(void* const* d_in, const int* in_sizes, int n_in, void* d_out, int out_size, void* d_ws, size_t ws_size, hipStream_t stream) {
    static int grid = 0;
    if (grid == 0) {
        if (n_in != 29 || out_size != O_END || ws_size < WS_END) { fprintf(stderr, "kernel_launch: unexpected shapes: n_in %d out %d ws %zu; nothing launched\n", n_in, out_size, ws_size); grid = -1; return; }
        int dev = 0, cus = 0, per_cu = 0;
        if (hipGetDevice(&dev) != hipSuccess || hipDeviceGetAttribute(&cus, hipDeviceAttributeMultiprocessorCount, dev) != hipSuccess) { fprintf(stderr, "kernel_launch: device query failed\n"); grid = -1; return; }
        if (hipFuncSetAttribute((const void*)fox_fwd, hipFuncAttributeMaxDynamicSharedMemorySize, LDS_BYTES) != hipSuccess) { fprintf(stderr, "kernel_launch: hipFuncSetAttribute failed\n"); grid = -1; return; }
        if (hipOccupancyMaxActiveBlocksPerMultiprocessor(&per_cu, (const void*)fox_fwd, NWAVES * 64, LDS_BYTES) != hipSuccess || per_cu < 1)
            fprintf(stderr, "kernel_launch: note: occupancy query reports %d workgroups per CU\n", per_cu);
        (void)hipGetLastError();
        grid = cus;
    }
    if (grid < 0) return;
    if (hipMemsetAsync((char*)d_ws + WS_CTL, 0, CTL_ZERO_BYTES, stream) != hipSuccess) { fprintf(stderr, "kernel_launch: memset failed\n"); return; }
    Args a{};
    for (int i = 0; i < 29; ++i) a.in[i] = d_in[i];
    a.out = (float*)d_out; a.ws = (unsigned char*)d_ws;
    if (ONE_LAUNCH) { a.ph_lo = 0; a.ph_hi = NPH; hipLaunchKernelGGL(fox_fwd, dim3(grid), dim3(NWAVES * 64), LDS_BYTES, stream, a); }
    else for (int p = 0; p < NPH; ++p) { a.ph_lo = p; a.ph_hi = p + 1; hipLaunchKernelGGL(fox_fwd, dim3(grid), dim3(NWAVES * 64), LDS_BYTES, stream, a); }
    const hipError_t le = hipPeekAtLastError();
    if (le != hipSuccess) fprintf(stderr, "kernel_launch: launch failed: %s\n", hipGetErrorName(le));
}
```
